# Optimizing an MI355X kernel written in HIP

```python
import jax, jax.numpy as jnp
from jax import lax
import numpy as np

D_MODEL = 1024
BATCH = 32
SEQ = 2048
DEPTH = 2

N_MIXERS = 2
N_CONV_LAYERS = (DEPTH + 1) // 2
N_RET_LAYERS = DEPTH // 2
CONV_WIDTH = 3
RET_HEADS = 4
RET_QK_DIM = D_MODEL // RET_HEADS
RET_V_DIM = 2 * RET_QK_DIM
RET_QK_WIDTH = RET_HEADS * RET_QK_DIM
RET_V_WIDTH = RET_HEADS * RET_V_DIM
RET_CHUNK = 128
ROPE_BASE = 10000.0
N_EXPERTS = 16
EC_CAPACITY_FACTOR = 2
EXPERT_FF = 2 * D_MODEL
PLE_DIM = 256
NORM_EPS = 1e-6
GN_EPS = 1e-5

kernel_name = "hybrid_conv_retention_ec_moe_encoder"


def rms_norm(x, g):
    xf = x.astype(jnp.float32)
    y = xf * lax.rsqrt(jnp.mean(xf * xf, axis=-1, keepdims=True) + NORM_EPS)
    return (y * g.astype(jnp.float32)).astype(x.dtype)


def short_conv_mixer(h, w_in, w_conv, b_conv, w_out):
    b_gate, c_gate, v = jnp.split(h @ w_in, 3, axis=-1)
    u = c_gate * v
    kern = w_conv[:, None, :].astype(u.dtype)
    pad = CONV_WIDTH // 2
    y = lax.conv_general_dilated(u, kern, window_strides=(1,), padding=((pad, pad),),
                                 dimension_numbers=('NWC', 'WIO', 'NWC'),
                                 feature_group_count=u.shape[-1]) + b_conv.astype(u.dtype)
    return (b_gate * y) @ w_out


def rotate(x, pos):
    half = x.shape[-1] // 2
    inv = ROPE_BASE ** (-jnp.arange(half, dtype=jnp.float32) / half)
    ang = pos.astype(jnp.float32)[:, None] * inv[None, :]
    cos = jnp.cos(ang)[:, None, :]
    sin = jnp.sin(ang)[:, None, :]
    x1, x2 = x[..., :half], x[..., half:]
    return jnp.concatenate([x1 * cos - x2 * sin, x1 * sin + x2 * cos], axis=-1)


def retention_one_direction(q, k, v, log_gamma, strict):
    b, h, s, dk = q.shape
    dv = v.shape[-1]
    L = RET_CHUNK
    n = s // L
    lg = log_gamma.astype(jnp.float32)
    idx = jnp.arange(L, dtype=jnp.float32)
    diff = idx[:, None] - idx[None, :]
    mask = (diff > 0) if strict else (diff >= 0)
    intra_decay = jnp.where(mask[None], jnp.exp(lg[:, None, None] * jnp.where(mask, diff, 0.0)[None]), 0.0)
    q_decay = jnp.exp(lg[:, None] * (idx[None, :] + 1.0))
    k_decay = jnp.exp(lg[:, None] * (L - 1.0 - idx[None, :]))
    chunk_decay = jnp.exp(lg * L)

    def to_chunks(t):
        return jnp.moveaxis(t.reshape(b, h, n, L, t.shape[-1]), 2, 0)

    def step(state, inp):
        qi, ki, vi = inp
        scores = jnp.einsum('bhid,bhjd->bhij', qi, ki) * intra_decay[None]
        intra = jnp.einsum('bhij,bhjv->bhiv', scores, vi)
        cross = jnp.einsum('bhld,bhdv->bhlv', qi * q_decay[None, :, :, None], state)
        state = state * chunk_decay[None, :, None, None] + jnp.einsum(
            'bhld,bhlv->bhdv', ki * k_decay[None, :, :, None], vi)
        return state, intra + cross

    init = jnp.zeros((b, h, dk, dv), jnp.float32)
    _, out = lax.scan(step, init, (to_chunks(q), to_chunks(k), to_chunks(v)))
    return jnp.moveaxis(out, 0, 2).reshape(b, h, s, dv)


def retention_mixer(h, w_in, log_decay, w_out):
    b, s, _ = h.shape
    proj = h @ w_in
    q, k, v, g = jnp.split(proj, [RET_QK_WIDTH, 2 * RET_QK_WIDTH, 2 * RET_QK_WIDTH + RET_V_WIDTH], axis=-1)
    pos = jnp.arange(s)
    q = rotate(q.reshape(b, s, RET_HEADS, RET_QK_DIM).astype(jnp.float32), pos)
    k = rotate(k.reshape(b, s, RET_HEADS, RET_QK_DIM).astype(jnp.float32), pos) * (RET_QK_DIM ** -0.5)
    v = v.reshape(b, s, RET_HEADS, RET_V_DIM).astype(jnp.float32)
    q, k, v = (jnp.transpose(t, (0, 2, 1, 3)) for t in (q, k, v))
    fwd = retention_one_direction(q, k, v, log_decay[0], strict=False)
    bwd = jnp.flip(retention_one_direction(jnp.flip(q, 2), jnp.flip(k, 2), jnp.flip(v, 2),
                                           log_decay[1], strict=True), 2)
    o = fwd + bwd
    mu = jnp.mean(o, axis=-1, keepdims=True)
    var = jnp.mean(jnp.square(o - mu), axis=-1, keepdims=True)
    o = (o - mu) * lax.rsqrt(var + GN_EPS)
    o = jnp.transpose(o, (0, 2, 1, 3)).reshape(b, s, RET_V_WIDTH).astype(h.dtype)
    return (jax.nn.silu(g) * o) @ w_out


def expert_choice_ffn(h, router_w, w_gate, w_up, w_down):
    b, s, _ = h.shape
    cap = EC_CAPACITY_FACTOR * s // N_EXPERTS
    logits = jnp.einsum('bsd,de->bse', h.astype(jnp.float32), router_w.astype(jnp.float32))
    affinity = jax.nn.softmax(logits, axis=-1)
    gates, tok = lax.top_k(jnp.swapaxes(affinity, 1, 2), cap)
    tok_e = jnp.swapaxes(tok, 0, 1)
    gates_e = jnp.swapaxes(gates, 0, 1)
    bidx = jnp.arange(b)[:, None]

    def run_expert(args):
        wg, wu, wd, t = args
        xe = h[bidx, t]
        return (jax.nn.silu(xe @ wg) * (xe @ wu)) @ wd

    y = lax.map(run_expert, (w_gate, w_up, w_down, tok_e))
    y = y * gates_e[..., None].astype(y.dtype)
    return jnp.zeros_like(h).at[jnp.arange(b)[None, :, None], tok_e].add(y)


def setup_inputs(seed: int = 0) -> dict:
    key = jax.random.key(seed)
    ks = jax.random.split(key, 20)
    f32 = jnp.float32
    D, E, F = D_MODEL, N_EXPERTS, EXPERT_FF

    def w(k, shape, fan_in):
        return jax.random.normal(k, shape, f32) * (fan_in ** -0.5)

    base_decay = jnp.log(1.0 - 2.0 ** (-5.0 - jnp.arange(RET_HEADS, dtype=f32)))
    ret_log_decay = base_decay[None, None, :] * (1.0 + 0.05 * jax.random.normal(ks[10], (N_RET_LAYERS, 2, RET_HEADS), f32))
    return {
        "x": jax.random.normal(ks[0], (BATCH, SEQ, D), f32),
        "p": jax.random.normal(ks[1], (DEPTH, BATCH, SEQ, PLE_DIM), f32),
        "norm_mix": 1.0 + 0.01 * jax.random.normal(ks[2], (DEPTH, D), f32),
        "norm_ffn": 1.0 + 0.01 * jax.random.normal(ks[3], (DEPTH, D), f32),
        "norm_ple": 1.0 + 0.01 * jax.random.normal(ks[4], (DEPTH, D), f32),
        "final_norm": 1.0 + 0.01 * jax.random.normal(ks[5], (D,), f32),
        "conv_w_in": w(ks[6], (N_CONV_LAYERS, D, 3 * D), D),
        "conv_w": w(ks[7], (N_CONV_LAYERS, CONV_WIDTH, D), CONV_WIDTH),
        "conv_b": 0.01 * jax.random.normal(ks[8], (N_CONV_LAYERS, D), f32),
        "conv_w_out": w(ks[9], (N_CONV_LAYERS, D, D), D),
        "ret_w_in": w(ks[11], (N_RET_LAYERS, D, 2 * RET_QK_WIDTH + 2 * RET_V_WIDTH), D),
        "ret_log_decay": ret_log_decay,
        "ret_w_out": w(ks[12], (N_RET_LAYERS, RET_V_WIDTH, D), RET_V_WIDTH),
        "router_w": w(ks[13], (DEPTH, D, E), D),
        "exp_w_gate": w(ks[14], (DEPTH, E, D, F), D),
        "exp_w_up": w(ks[15], (DEPTH, E, D, F), D),
        "exp_w_down": w(ks[16], (DEPTH, E, F, D), F),
        "ple_w_proj": w(ks[17], (DEPTH, PLE_DIM, D), PLE_DIM),
        "ple_w_gate": w(ks[18], (DEPTH, D, D), D),
    }


def reference(x, p, norm_mix, norm_ffn, norm_ple, final_norm, conv_w_in, conv_w, conv_b, conv_w_out,
              ret_w_in, ret_log_decay, ret_w_out, router_w, exp_w_gate, exp_w_up, exp_w_down,
              ple_w_proj, ple_w_gate):
    h = x
    for i in range(DEPTH):
        j = i // N_MIXERS
        hn = rms_norm(h, norm_mix[i])
        if i % N_MIXERS == 0:
            mix = short_conv_mixer(hn, conv_w_in[j], conv_w[j], conv_b[j], conv_w_out[j])
        else:
            mix = retention_mixer(hn, ret_w_in[j], ret_log_decay[j], ret_w_out[j])
        h = h + mix
        h = h + expert_choice_ffn(rms_norm(h, norm_ffn[i]), router_w[i], exp_w_gate[i], exp_w_up[i], exp_w_down[i])
        gate = jax.nn.sigmoid(rms_norm(h, norm_ple[i]) @ ple_w_gate[i])
        h = h + gate * (p[i].astype(h.dtype) @ ple_w_proj[i])
    return rms_norm(h, final_norm)
```

```cpp
#include <hip/hip_runtime.h>
#include <cstdio>
#include <cstdint>

#ifndef MK_DUP
#define MK_DUP -1
#endif
#ifndef MK_RET_I8
#define MK_RET_I8 1
#endif
#define QA_HN 32.0f
#define QA_ACT 16.0f
#define QW_1024 1024.0f
#define QW_2048 1408.0f
#define QA_PP 32.0f
#define QA_T 40.0f
#define QA_QK 32.0f
#ifndef QA_OG
#define QA_OG 16.0f
#endif
#ifndef MK_PER_PHASE
#define MK_PER_PHASE 0
#endif

namespace pg8 {
#define PG8_LAS __attribute__((address_space(3)))
typedef unsigned short bf16_t;
typedef short bf16x8 __attribute__((ext_vector_type(8)));
typedef float f32x2 __attribute__((ext_vector_type(2)));
typedef float f32x4 __attribute__((ext_vector_type(4)));
typedef float f32x16 __attribute__((ext_vector_type(16)));
typedef unsigned u32x4 __attribute__((ext_vector_type(4)));
typedef unsigned u32x2 __attribute__((ext_vector_type(2)));
typedef int i32x4 __attribute__((ext_vector_type(4)));
typedef int i32x8 __attribute__((ext_vector_type(8)));
constexpr int BM = 256, BK = 64, HALF = 128, HTB = HALF * BK * 2, STAGE_BYTES = 8 * HTB, NXCD = 8, WGM = 8;

__host__ __device__ __forceinline__ int lds_byte(int r, int c) { const int st = (r >> 4) * 2 + (c >> 5), rr = r & 15, cc = c & 31, ob = rr * 64 + cc * 2; return st * 1024 + (ob ^ (((ob >> 9) & 1) << 5)); }
__host__ __device__ __forceinline__ void stage_rc(int b, int& R, int& C) { const int st = b / 1024, sb = b % 1024, swz = sb ^ (((sb >> 9) & 1) << 5); R = (st >> 1) * 16 + swz / 64; C = (st & 1) * 32 + (swz % 64) / 2; }
__host__ __device__ __forceinline__ int perm32(int rho) { const int n = rho >> 4, i = rho & 15; return 8 * (i >> 2) + 4 * n + (i & 3); }

struct Unit { int pm, pn; };

struct StaticOrder {
    int nM, nN, nwg, G, c;
    __device__ __forceinline__ void init(int M, int N, int G_, int c_) { nM = M / BM; nN = N / BM; nwg = nM * nN; G = G_; c = c_; }
    __device__ __forceinline__ bool next(int i, Unit& u) const {
        const long L = (long)i * G + c; if (L >= nwg) return false;
        int wgid = (int)L; { const int q = nwg / NXCD, r = nwg % NXCD, xcd = wgid % NXCD, off = wgid / NXCD; wgid = (xcd < r ? xcd * (q + 1) : r * (q + 1) + (xcd - r) * q) + off; }
        const int nig = WGM * nN, gid = wgid / nig, fm = gid * WGM, gsz = (nM - fm) < WGM ? (nM - fm) : WGM;
        u.pm = fm + ((wgid % nig) % gsz); u.pn = (wgid % nig) / gsz; return true;
    }
};
struct ExpertOrder {
    int nN, total, G, c;
    __device__ __forceinline__ void init(int nN_, int G_, int c_) { nN = nN_; total = 16 * 32 * nN_; G = G_; c = c_; }
    __device__ __forceinline__ bool next(int i, Unit& u) const {
        const long L = (long)i * G + c; if (L >= total) return false;
        const int l = (int)L, V = (l % NXCD) * (total / NXCD) + l / NXCD;
        const int per_e = 32 * nN, e = V / per_e, w = V % per_e, grp = 8 * nN, gq = w / grp, idx = w % grp;
        u.pm = e * 32 + gq * 8 + (idx & 7); u.pn = idx >> 3; return true;
    }
};

__device__ __forceinline__ unsigned cvt_pk_bf16(float lo, float hi) { unsigned r; asm volatile("v_cvt_pk_bf16_f32 %0, %1, %2" : "=v"(r) : "v"(lo), "v"(hi)); return r; }
__device__ __forceinline__ float bf_lo(unsigned w) { return __uint_as_float(w << 16); }
__device__ __forceinline__ float bf_hi(unsigned w) { return __uint_as_float(w & 0xffff0000u); }
__device__ __forceinline__ float clamp_f8(float x) { return fminf(fmaxf(x, -448.f), 448.f); }
__device__ __forceinline__ unsigned q8(float v, float sc) { float t = rintf(v * sc); t = fminf(fmaxf(t, -127.f), 127.f); return (unsigned)(int)t & 0xffu; }
__device__ __forceinline__ float fast_sigmoid(float x) { return __builtin_amdgcn_rcpf(1.0f + __builtin_amdgcn_exp2f(-1.44269504089f * x)); }
__device__ __forceinline__ float fast_silu(float x) { return x * fast_sigmoid(x); }
__device__ __forceinline__ f32x2 sigmoid_s2(const f32x2 a, const float s) {
    const f32x2 e = a * (f32x2){-1.44269504089f * s, -1.44269504089f * s};
    const f32x2 d = (f32x2){__builtin_amdgcn_exp2f(e[0]), __builtin_amdgcn_exp2f(e[1])} + (f32x2){1.0f, 1.0f};
    return (f32x2){__builtin_amdgcn_rcpf(d[0]), __builtin_amdgcn_rcpf(d[1])};
}
__device__ __forceinline__ unsigned pack4_i8(const f32x4 v) {
    const f32x4 w = v + (f32x4){12582912.0f, 12582912.0f, 12582912.0f, 12582912.0f};
    const unsigned b0 = __float_as_uint(__builtin_amdgcn_fmed3f(w[0], 12582912.0f - 127.0f, 12582912.0f + 127.0f)), b1 = __float_as_uint(__builtin_amdgcn_fmed3f(w[1], 12582912.0f - 127.0f, 12582912.0f + 127.0f));
    const unsigned b2 = __float_as_uint(__builtin_amdgcn_fmed3f(w[2], 12582912.0f - 127.0f, 12582912.0f + 127.0f)), b3 = __float_as_uint(__builtin_amdgcn_fmed3f(w[3], 12582912.0f - 127.0f, 12582912.0f + 127.0f));
    return __builtin_amdgcn_perm(b1, b0, 0x0c0c0400u) | __builtin_amdgcn_perm(b3, b2, 0x04000c0cu);
}

struct SrcPlain {
    static constexpr bool GATHER = false;
    const bf16_t* A; const bf16_t* Bt; int K;
    __device__ __forceinline__ const char* a_base(const Unit& u) const { return (const char*)(A + (size_t)u.pm * BM * K); }
    __device__ __forceinline__ const char* b_base(const Unit& u) const { return (const char*)(Bt + (size_t)u.pn * BM * K); }
};
struct SrcExpert2 {
    static constexpr bool GATHER = false;
    const bf16_t* A; const bf16_t* Bt; int K;
    __device__ __forceinline__ const char* a_base(const Unit& u) const { return (const char*)(A + (size_t)u.pm * BM * K); }
    __device__ __forceinline__ const char* b_base(const Unit& u) const { return (const char*)(Bt + ((size_t)(u.pm >> 5) * 1024 + (size_t)u.pn * BM) * K); }
};
struct SrcExpert1 {
    static constexpr bool GATHER = true;
    const bf16_t* A; const bf16_t* Bt; int K; const PG8_LAS unsigned short* tok;
    __device__ __forceinline__ const char* a_base(const Unit&) const { return (const char*)A; }
    __device__ __forceinline__ const char* b_base(const Unit& u) const { return (const char*)(Bt + ((size_t)(u.pm >> 5) * 4096 + (size_t)u.pn * BM) * K); }
    __device__ __forceinline__ unsigned a_off(const Unit& u, int round, int r, int C) const {
        const unsigned t = tok[round * 256 + r]; return (((unsigned)(u.pm & 31) * 2048u + t) * (unsigned)K + (unsigned)C) * 2u; }
};

template <int MODE  , class Epi, class Sched, class Src>
__device__ __forceinline__ void gemm_phase(PG8_LAS unsigned char* lds, const Sched& S, const Src& X, const Epi& E) {
    int tid_ = threadIdx.x; asm volatile("" : "+v"(tid_));
    const int tid = tid_, wid = __builtin_amdgcn_readfirstlane(tid >> 6), lane = tid & 63, wr = wid >> 2, wc = wid & 3, fr = lane & 15, fq = lane >> 4;
    const int K = X.K, nt = K / BK;
    unsigned voffA[2], voffB[2]; unsigned ocur[2][2], onxt[2][2]; int sR[2], sC[2];
    const size_t kstep = (size_t)(BK * 2);
    const size_t hstep = (size_t)HALF * K * 2;
#pragma unroll
    for (int i = 0; i < 2; ++i) { int R, C; stage_rc(tid * 16 + i * 8192, R, C); const int Rb = Epi::PERM ? ((R & ~31) + perm32(R & 31)) : R;
        sR[i] = R; sC[i] = C; voffB[i] = (unsigned)(Rb * K + C) * 2u; voffA[i] = (unsigned)(R * K + C) * 2u;
        ocur[0][i] = 0u; ocur[1][i] = 0u; onxt[0][i] = 0u; onxt[1][i] = 0u; }
    const unsigned ldsw = (unsigned)wid * 1024u;
    const int aoff = lds_byte(wr * 64 + fr, fq * 8), boff = lds_byte(wc * 32 + fr, fq * 8);
#define PG8_SA(b, h) (((b) * 2 + (h)) * HTB)
#define PG8_SB(b, h) ((4 + (b) * 2 + (h)) * HTB)
#define PG8_STAGE(bufoff, gbase, voff) do { _Pragma("unroll") for (int _i = 0; _i < 2; ++_i) \
        __builtin_amdgcn_global_load_lds((const unsigned*)((const char*)(gbase) + (voff)[_i]), (PG8_LAS unsigned*)(lds + (bufoff) + ldsw + _i * 8192), 16, 0, 0); } while (0)
#define PG8_STAGE_A(bufoff, ptr, h, OFF) do { if constexpr (Src::GATHER) { PG8_STAGE(bufoff, ptr, OFF[h]); } else { PG8_STAGE(bufoff, (ptr) + (h) * hstep, voffA); } } while (0)
#define PG8_LDA(dst, b, h) do { _Pragma("unroll") for (int m = 0; m < 4; ++m) { if constexpr (MODE == 2) { const i32x4 lo_ = *(const PG8_LAS i32x4*)(lds + PG8_SA(b, h) + aoff + m * 2048), hi_ = *(const PG8_LAS i32x4*)(lds + PG8_SA(b, h) + aoff + m * 2048 + 1024); dst##8[m] = __builtin_shufflevector(lo_, hi_, 0, 1, 2, 3, 4, 5, 6, 7); } \
        else { _Pragma("unroll") for (int k = 0; k < 2; ++k) dst[m][k] = *(const PG8_LAS bf16x8*)(lds + PG8_SA(b, h) + aoff + m * 2048 + k * 1024); } } } while (0)
#define PG8_LDB(dst, b, h) do { _Pragma("unroll") for (int n = 0; n < 2; ++n) { if constexpr (MODE == 2) { const i32x4 lo_ = *(const PG8_LAS i32x4*)(lds + PG8_SB(b, h) + boff + n * 2048), hi_ = *(const PG8_LAS i32x4*)(lds + PG8_SB(b, h) + boff + n * 2048 + 1024); dst##8[n] = __builtin_shufflevector(lo_, hi_, 0, 1, 2, 3, 4, 5, 6, 7); } \
        else { _Pragma("unroll") for (int k = 0; k < 2; ++k) dst[n][k] = *(const PG8_LAS bf16x8*)(lds + PG8_SB(b, h) + boff + n * 2048 + k * 1024); } } } while (0)
#define PG8_MMA(ai, bj, At, Bt) do { __builtin_amdgcn_s_setprio(1); _Pragma("unroll") for (int m = 0; m < 4; ++m) _Pragma("unroll") for (int n = 0; n < 2; ++n) _Pragma("unroll") for (int k = 0; k < 2; ++k) { \
        if constexpr (MODE == 0) acc[ai][bj][m][n] = __builtin_amdgcn_mfma_f32_16x16x32_bf16(Bt[n][k], At[m][k], acc[ai][bj][m][n], 0, 0, 0); \
        else if constexpr (MODE == 1) acc[ai][bj][m][n] = __builtin_bit_cast(f32x4, __builtin_amdgcn_mfma_i32_16x16x64_i8(__builtin_bit_cast(i32x4, Bt[n][k]), __builtin_bit_cast(i32x4, At[m][k]), __builtin_bit_cast(i32x4, acc[ai][bj][m][n]), 0, 0, 0)); \
        else if (k == 0) acc[ai][bj][m][n] = __builtin_amdgcn_mfma_scale_f32_16x16x128_f8f6f4(Bt##8[n], At##8[m], acc[ai][bj][m][n], 0, 0, 0, 0x7f7f7f7f, 0, 0x7f7f7f7f); } \
        __builtin_amdgcn_s_setprio(0); } while (0)
#define PG8_WAIT_V(n) asm volatile("s_waitcnt vmcnt(" #n ")" ::: "memory")
#define PG8_WAIT_L(n) asm volatile("s_waitcnt lgkmcnt(" #n ")" ::: "memory")
#define PG8_BAR __builtin_amdgcn_s_barrier()
#define PG8_SCHED __builtin_amdgcn_sched_barrier(0)
    Unit cur, nxt; int ui = 0;
    if (!S.next(0, cur)) return;
    f32x4 acc[2][2][4][2];
#pragma unroll
    for (int a = 0; a < 2; ++a)
#pragma unroll
        for (int b = 0; b < 2; ++b)
#pragma unroll
            for (int m = 0; m < 4; ++m)
#pragma unroll
                for (int n = 0; n < 2; ++n) acc[a][b][m][n] = (f32x4){0.f, 0.f, 0.f, 0.f};
    bf16x8 At[4][2], B0[2][2], B1[2][2]; i32x8 At8[4], B08[2], B18[2];
    const char* cA = X.a_base(cur); const char* cB = X.b_base(cur);
    if constexpr (Src::GATHER) {
#pragma unroll
        for (int h = 0; h < 2; ++h)
#pragma unroll
            for (int i = 0; i < 2; ++i) ocur[h][i] = X.a_off(cur, 0, h * HALF + sR[i], sC[i]);
        PG8_WAIT_L(0);
    }
    PG8_STAGE(PG8_SB(0, 0), cB, voffB); PG8_STAGE(PG8_SB(0, 1), cB + hstep, voffB); PG8_STAGE_A(PG8_SA(0, 0), cA, 0, ocur); PG8_STAGE_A(PG8_SA(0, 1), cA, 1, ocur);
    if (wr == 1) PG8_BAR;
    PG8_WAIT_V(2); PG8_BAR;
    PG8_STAGE(PG8_SB(1, 0), cB + kstep, voffB); PG8_STAGE_A(PG8_SA(1, 0), cA + kstep, 0, ocur); PG8_STAGE(PG8_SB(1, 1), cB + hstep + kstep, voffB);
    PG8_WAIT_V(6); PG8_BAR;
    for (;;) {
        const bool has_next = S.next(ui + 1, nxt);
        const char* nA = has_next ? X.a_base(nxt) : cA; const char* nB = has_next ? X.b_base(nxt) : cB;
        for (int t = 0; t < nt; t += 2) {
            const bool last = (t == nt - 2);
            const char* a1 = cA + (size_t)(t + 1) * kstep;
            const char* a2 = last ? nA : cA + (size_t)(t + 2) * kstep; const char* b2 = last ? nB : cB + (size_t)(t + 2) * kstep;
            const char* a3 = a2 + kstep; const char* b3 = b2 + kstep;
            unsigned o2[2][2];
            if constexpr (Src::GATHER) {
                if (last && has_next) {
#pragma unroll
                    for (int h = 0; h < 2; ++h)
#pragma unroll
                        for (int i = 0; i < 2; ++i) onxt[h][i] = X.a_off(nxt, ui + 1, h * HALF + sR[i], sC[i]);
                    PG8_WAIT_L(0);
                }
#pragma unroll
                for (int h = 0; h < 2; ++h)
#pragma unroll
                    for (int i = 0; i < 2; ++i) o2[h][i] = (last && has_next) ? onxt[h][i] : ocur[h][i];
            } else {
#pragma unroll
                for (int h = 0; h < 2; ++h)
#pragma unroll
                    for (int i = 0; i < 2; ++i) o2[h][i] = ocur[h][i];
            }
            PG8_LDB(B0, 0, 0); PG8_LDB(B1, 0, 1); PG8_SCHED; PG8_LDA(At, 0, 0); PG8_STAGE_A(PG8_SA(1, 1), a1, 1, ocur);
            PG8_WAIT_V(8); PG8_WAIT_L(0); PG8_BAR; PG8_MMA(0, 0, At, B0); PG8_MMA(0, 1, At, B1); PG8_BAR; PG8_SCHED;
            PG8_LDA(At, 0, 1); PG8_STAGE(PG8_SB(0, 0), b2, voffB); PG8_STAGE(PG8_SB(0, 1), b2 + hstep, voffB); PG8_STAGE_A(PG8_SA(0, 0), a2, 0, o2);
            PG8_WAIT_V(8); PG8_WAIT_L(0); PG8_BAR; PG8_MMA(1, 0, At, B0); PG8_MMA(1, 1, At, B1); PG8_BAR; PG8_SCHED;
            PG8_LDB(B0, 1, 0); PG8_LDB(B1, 1, 1); PG8_SCHED; PG8_LDA(At, 1, 0); PG8_STAGE_A(PG8_SA(0, 1), a2, 1, o2);
            PG8_WAIT_V(8); PG8_WAIT_L(0); PG8_BAR; PG8_MMA(0, 0, At, B0); PG8_MMA(0, 1, At, B1); PG8_BAR; PG8_SCHED;
            PG8_LDA(At, 1, 1); PG8_STAGE(PG8_SB(1, 0), b3, voffB); PG8_STAGE(PG8_SB(1, 1), b3 + hstep, voffB); PG8_STAGE_A(PG8_SA(1, 0), a3, 0, o2);
            PG8_WAIT_V(8); PG8_WAIT_L(0); PG8_BAR; PG8_MMA(1, 0, At, B0); PG8_MMA(1, 1, At, B1); PG8_BAR; PG8_SCHED;
        }
        if (wr == 0) PG8_BAR;
        if constexpr (MODE == 1 && !Epi::RAW_I32) {
#pragma unroll
            for (int a = 0; a < 2; ++a)
#pragma unroll
                for (int b = 0; b < 2; ++b)
#pragma unroll
                    for (int m = 0; m < 4; ++m)
#pragma unroll
                        for (int n = 0; n < 2; ++n) { const i32x4 iv = __builtin_bit_cast(i32x4, acc[a][b][m][n]); acc[a][b][m][n] = (f32x4){(float)iv[0], (float)iv[1], (float)iv[2], (float)iv[3]}; }
        }
        E(acc, cur, wr, wc, fr, fq);
        if (!has_next) break;
#pragma unroll
        for (int a = 0; a < 2; ++a)
#pragma unroll
            for (int b = 0; b < 2; ++b)
#pragma unroll
                for (int m = 0; m < 4; ++m)
#pragma unroll
                    for (int n = 0; n < 2; ++n) acc[a][b][m][n] = (f32x4){0.f, 0.f, 0.f, 0.f};
        cur = nxt; cA = nA; cB = nB; ++ui;
        if constexpr (Src::GATHER) {
#pragma unroll
            for (int h = 0; h < 2; ++h)
#pragma unroll
                for (int i = 0; i < 2; ++i) ocur[h][i] = onxt[h][i];
        }
        if (wr == 1) PG8_BAR;
    }
    PG8_WAIT_V(0);
    PG8_BAR;
#undef PG8_SA
#undef PG8_SB
#undef PG8_STAGE
#undef PG8_STAGE_A
#undef PG8_LDA
#undef PG8_LDB
#undef PG8_MMA
#undef PG8_WAIT_V
#undef PG8_WAIT_L
#undef PG8_BAR
#undef PG8_SCHED
}
}

constexpr int D = 1024, BATCH = 32, SEQ = 2048, T = BATCH * SEQ, NE = 16, CAP = 256, FF = 2048, PLE = 256;
constexpr int RH = 4, RQK = 256, RV = 512, RQW = 1024, RVW = 2048;
constexpr int NWAVES = 8, NTHREADS = 512;
constexpr float NORM_EPS = 1e-6f, GN_EPS = 1e-5f;

constexpr size_t MiB = 1u << 20;
constexpr size_t WS_CTL = 0, CTL_ZERO_BYTES = 1 * MiB;
constexpr size_t WS_AFF = 2 * MiB;
constexpr size_t WS_INV = 6 * MiB;
constexpr size_t WS_TOK = 10 * MiB;
constexpr size_t WS_GATE = 11 * MiB;
constexpr size_t WS_ROPE = 12 * MiB;
constexpr size_t WS_WCI = 16 * MiB;
constexpr size_t WS_WCO = 22 * MiB;
constexpr size_t WS_WRI = 24 * MiB;
constexpr size_t WS_WRO = 36 * MiB;
constexpr size_t WS_WPG = 40 * MiB;
constexpr size_t WS_WPP = 44 * MiB;
constexpr size_t WS_WE1 = 48 * MiB;
constexpr size_t WS_WE2 = 112 * MiB;
constexpr size_t WS_H16 = 144 * MiB;
constexpr size_t WS_HB = 272 * MiB;
constexpr size_t WS_SCR = 400 * MiB;
constexpr size_t WS_END = 1168 * MiB;
constexpr size_t SC_CB = 0, SC_CU = 128 * MiB, SC_CZ = 256 * MiB;
constexpr size_t SC_Q = 0, SC_K = 128 * MiB, SC_VT = 256 * MiB, SC_G = 512 * MiB;
constexpr size_t SC_ACT = 0, SC_Y = 512 * MiB;
constexpr size_t SC_PB = 0, SC_PP = 128 * MiB, SC_T = 256 * MiB;
constexpr size_t SC_D0 = 384 * MiB, SC_D7 = 0;
constexpr size_t SC_PB_UNUSED = 0;

constexpr int CW_BAR = 4096;

constexpr int RING_OFF = 0, RING_BYTES = 131072;
constexpr int TOK_OFF = RING_BYTES, TOK_BYTES = 32 * 256 * 2;
constexpr int MISC_OFF = TOK_OFF + TOK_BYTES;
constexpr int LDS_BYTES = MISC_OFF + 512;

#define GAS __attribute__((address_space(1)))
#define LAS __attribute__((address_space(3)))
typedef unsigned short bf16;
typedef unsigned v4u __attribute__((ext_vector_type(4)));
typedef unsigned v2u __attribute__((ext_vector_type(2)));
typedef float f32x4 __attribute__((ext_vector_type(4)));
typedef float f32x16 __attribute__((ext_vector_type(16)));
typedef short bf16x8 __attribute__((ext_vector_type(8)));
#define LDS_WAIT() asm volatile("s_waitcnt lgkmcnt(0)" ::: "memory")
#define VM_WAIT() asm volatile("s_waitcnt vmcnt(0)" ::: "memory")
__device__ __forceinline__ unsigned f2bf(float f) { unsigned u = __builtin_bit_cast(unsigned, f); return (u + 0x7fffu + ((u >> 16) & 1u)) >> 16; }
__device__ __forceinline__ unsigned pk2(float lo, float hi) { return f2bf(lo) | (f2bf(hi) << 16); }

#define XB_TMO      128
#define XB_XCNT(j)  (256  + 64 * (j))
#define XB_XSUB(j)  (1280 + 64 * (j))
#define XB_XGEN(j)  (2304 + 64 * (j))
#define XB_TOP      3328
#define XB_TOPGEN   3392
#define XCD_BAR_WORDS 3456
#define XB_SPIN_CAP (1u << 20)

__device__ __forceinline__ unsigned xb_ld(unsigned* p)              { return __hip_atomic_load(p, __ATOMIC_RELAXED, __HIP_MEMORY_SCOPE_AGENT); }
__device__ __forceinline__ unsigned xb_add(unsigned* p, unsigned v) { return __hip_atomic_fetch_add(p, v, __ATOMIC_RELAXED, __HIP_MEMORY_SCOPE_AGENT); }
__device__ __forceinline__ unsigned xb_xcc_id() { return (unsigned)__builtin_amdgcn_s_getreg((3 << 11) | 20) & 0xFu; }
#define XB_SPIN(cond, bar) do { unsigned _sp = 0; while (cond) { __builtin_amdgcn_s_sleep(1); \
    if ((++_sp & 255u) == 0u) { if (xb_ld(&(bar)[XB_TMO])) break; if (_sp > XB_SPIN_CAP) { atomicAdd(&(bar)[XB_TMO], 1u); break; } } } } while (0)

struct XcdBarrier { unsigned* bar; unsigned x; volatile LAS unsigned* st; };

__device__ __forceinline__ XcdBarrier xcd_barrier_post(unsigned* bar, volatile LAS unsigned* st) {
    XcdBarrier b; b.bar = bar; b.x = xb_xcc_id(); b.st = st;
    if (threadIdx.x == 0) (void)xb_add(&bar[XB_XCNT(b.x)], 1u);
    return b;
}
__device__ __forceinline__ void xcd_barrier_complete(unsigned* bar, unsigned x, unsigned& nloc, unsigned& nx) {
    const unsigned G = gridDim.x * gridDim.y * gridDim.z;
    unsigned sum, cnt, mine, sp = 0u;
    for (;;) {
        sum = 0u; cnt = 0u; mine = 0u;
#pragma unroll
        for (unsigned j = 0; j < 16; ++j) { const unsigned c = xb_ld(&bar[XB_XCNT(j)]); sum += c; cnt += (c > 0u) ? 1u : 0u; mine = (j == x) ? c : mine; }
        if (sum == G) break;
        __builtin_amdgcn_s_sleep(1);
        if ((++sp & 255u) == 0u) { if (xb_ld(&bar[XB_TMO])) break; if (sp > XB_SPIN_CAP) { atomicAdd(&bar[XB_TMO], 1u); break; } }
    }
    nloc = mine > 0u ? mine : 1u; nx = cnt > 0u ? cnt : 1u;
}
__device__ __forceinline__ void xcd_barrier(const XcdBarrier& b) {
    asm volatile("s_waitcnt vmcnt(0)" ::: "memory");
    __syncthreads();
    if (threadIdx.x == 0) {
        unsigned* bar = b.bar;
        __builtin_amdgcn_s_waitcnt(0);
        unsigned nloc = b.st[0], nx = b.st[1];
        if (nloc == 0u) { xcd_barrier_complete(bar, b.x, nloc, nx); b.st[0] = nloc; b.st[1] = nx; }
        const unsigned old = xb_add(&bar[XB_XSUB(b.x)], 1u);
        const unsigned gen = old / nloc;
        if (old + 1u == (gen + 1u) * nloc) {
            __builtin_amdgcn_fence(__ATOMIC_RELEASE, "agent");
            asm volatile("s_waitcnt vmcnt(0)" ::: "memory");
            const unsigned og = xb_add(&bar[XB_TOP], 1u);
            const unsigned tg = og / nx;
            if (og + 1u == (tg + 1u) * nx) xb_add(&bar[XB_TOPGEN], 1u);
            else XB_SPIN(xb_ld(&bar[XB_TOPGEN]) == tg, bar);
            __builtin_amdgcn_fence(__ATOMIC_ACQUIRE, "agent");
            xb_add(&bar[XB_XGEN(b.x)], 1u);
            asm volatile("s_waitcnt vmcnt(0)" ::: "memory");
        } else {
            XB_SPIN(xb_ld(&bar[XB_XGEN(b.x)]) == gen, bar);
            __builtin_amdgcn_fence(__ATOMIC_ACQUIRE, "agent");
            asm volatile("s_waitcnt vmcnt(0)" ::: "memory");
        }
    }
    __syncthreads();
}

__device__ __forceinline__ float wave_sum(float v) {
#pragma unroll
    for (int o = 1; o < 64; o <<= 1) v += __shfl_xor(v, o);
    return v;
}

namespace pg8 {
#define EPI_ROWLOOP _Pragma("unroll") for (int ai = 0; ai < 2; ++ai) _Pragma("unroll") for (int m = 0; m < 4; ++m)
__device__ __forceinline__ u32x4 pack8(const f32x4 a, const f32x4 b) { u32x4 w; w.x = cvt_pk_bf16(a[0], a[1]); w.y = cvt_pk_bf16(a[2], a[3]); w.z = cvt_pk_bf16(b[0], b[1]); w.w = cvt_pk_bf16(b[2], b[3]); return w; }

struct EpiBf16 {
    static constexpr bool PERM = true, RAW_I32 = false;
    bf16_t* O; int ldc; float qs;
    __device__ __forceinline__ void operator()(const f32x4 (&acc)[2][2][4][2], const Unit& u, int wr, int wc, int fr, int fq) const {
        const int row0 = u.pm * BM + wr * 64 + fr, col0 = u.pn * BM + wc * 32 + 8 * fq;
        EPI_ROWLOOP { bf16_t* rowp = O + (size_t)(row0 + ai * HALF + m * 16) * ldc + col0;
#pragma unroll
            for (int bj = 0; bj < 2; ++bj) *(u32x4*)(rowp + bj * HALF) = pack8(acc[ai][bj][m][0] * qs, acc[ai][bj][m][1] * qs); }
    }
};
struct EpiI8 {
    static constexpr bool PERM = true, RAW_I32 = false;
    unsigned char* O; int ldc; float qs;
    __device__ __forceinline__ void operator()(const f32x4 (&acc)[2][2][4][2], const Unit& u, int wr, int wc, int fr, int fq) const {
        const int row0 = u.pm * BM + wr * 64 + fr, col0 = u.pn * BM + wc * 32 + 8 * fq;
        EPI_ROWLOOP { unsigned char* rowp = O + (size_t)(row0 + ai * HALF + m * 16) * ldc + col0;
#pragma unroll
            for (int bj = 0; bj < 2; ++bj) { u32x2 w8; w8.x = pack4_i8(acc[ai][bj][m][0] * qs); w8.y = pack4_i8(acc[ai][bj][m][1] * qs); *(u32x2*)(rowp + bj * HALF) = w8; } }
    }
};
struct EpiConvIn {
    static constexpr bool PERM = true, RAW_I32 = false;
    bf16_t* Bb; bf16_t* Ub; float qs;
    __device__ __forceinline__ void operator()(const f32x4 (&acc)[2][2][4][2], const Unit& u, int wr, int wc, int fr, int fq) const {
        const int row0 = u.pm * BM + wr * 64 + fr;
        if (u.pn < 4) {
            const int col0 = u.pn * BM + wc * 32 + 8 * fq;
            EPI_ROWLOOP { bf16_t* rowp = Bb + (size_t)(row0 + ai * HALF + m * 16) * D_ + col0;
#pragma unroll
                for (int bj = 0; bj < 2; ++bj) *(u32x4*)(rowp + bj * HALF) = pack8(acc[ai][bj][m][0] * qs, acc[ai][bj][m][1] * qs); }
        } else {
            const int ch0 = (u.pn - 4) * HALF + wc * 32 + 8 * fq;
            EPI_ROWLOOP { bf16_t* rowp = Ub + (size_t)(row0 + ai * HALF + m * 16) * D_ + ch0;
                const float q2 = qs * qs;
                *(u32x4*)rowp = pack8(acc[ai][0][m][0] * acc[ai][1][m][0] * q2, acc[ai][0][m][1] * acc[ai][1][m][1] * q2); }
        }
    }
    static constexpr int D_ = 1024;
};
struct EpiSwiglu {
    static constexpr bool PERM = true, RAW_I32 = true; static constexpr float QS = 1.0f / (QA_HN * QW_1024);
    bf16_t* O;
    __device__ __forceinline__ f32x2 q2(float g0, float g1, float u0, float u1) const {
        const f32x2 ga = {(float)__float_as_int(g0), (float)__float_as_int(g1)}, ua = {(float)__float_as_int(u0), (float)__float_as_int(u1)};
        const f32x2 x = ga * (f32x2){-1.44269504089f * QS, -1.44269504089f * QS};
        const f32x2 d = (f32x2){__builtin_amdgcn_exp2f(x[0]), __builtin_amdgcn_exp2f(x[1])} + (f32x2){1.0f, 1.0f};
        const f32x2 sg = {__builtin_amdgcn_rcpf(d[0]), __builtin_amdgcn_rcpf(d[1])};
        f32x2 v = (ga * ua) * sg;
        v = v * (f32x2){QS * QS * QA_ACT, QS * QS * QA_ACT} + (f32x2){12582912.0f, 12582912.0f};
        v[0] = __builtin_amdgcn_fmed3f(v[0], 12582912.0f - 127.0f, 12582912.0f + 127.0f); v[1] = __builtin_amdgcn_fmed3f(v[1], 12582912.0f - 127.0f, 12582912.0f + 127.0f);
        return v;
    }
    __device__ __forceinline__ void operator()(const f32x4 (&acc)[2][2][4][2], const Unit& u, int wr, int wc, int fr, int fq) const {
        const int row0 = u.pm * BM + wr * 64 + fr, ch0 = u.pn * HALF + wc * 32 + 8 * fq;
        EPI_ROWLOOP { unsigned char* rowp = (unsigned char*)O + (size_t)(row0 + ai * HALF + m * 16) * 2048 + ch0;
            u32x2 w8;
#pragma unroll
            for (int n = 0; n < 2; ++n) { const f32x4 g = acc[ai][0][m][n], up = acc[ai][1][m][n];
                const f32x2 w01 = q2(g[0], g[1], up[0], up[1]), w23 = q2(g[2], g[3], up[2], up[3]);
                const unsigned b0 = __float_as_uint(w01[0]), b1 = __float_as_uint(w01[1]), b2 = __float_as_uint(w23[0]), b3 = __float_as_uint(w23[1]);
                const unsigned lo = __builtin_amdgcn_perm(b1, b0, 0x0c0c0400u), hi = __builtin_amdgcn_perm(b3, b2, 0x04000c0cu);
                const unsigned wv = lo | hi;
                if (n == 0) w8.x = wv; else w8.y = wv; }
            *(u32x2*)rowp = w8; }
    }
};
struct EpiDown {
    static constexpr bool PERM = true, RAW_I32 = false;
    bf16_t* O; const float* gate;
    __device__ __forceinline__ void operator()(const f32x4 (&acc)[2][2][4][2], const Unit& u, int wr, int wc, int fr, int fq) const {
        const int row0 = u.pm * BM + wr * 64 + fr, col0 = u.pn * BM + wc * 32 + 8 * fq;
        float gtv[2][4];
#pragma unroll
        for (int ai = 0; ai < 2; ++ai)
#pragma unroll
            for (int m = 0; m < 4; ++m) gtv[ai][m] = gate[row0 + ai * HALF + m * 16];
        EPI_ROWLOOP { const int row = row0 + ai * HALF + m * 16; const float gt = gtv[ai][m] * (1.0f / (QA_ACT * QW_2048))  ; bf16_t* rowp = O + (size_t)row * 1024 + col0;
#pragma unroll
            for (int bj = 0; bj < 2; ++bj) *(u32x4*)(rowp + bj * HALF) = pack8(acc[ai][bj][m][0] * gt, acc[ai][bj][m][1] * gt); }
    }
};
struct EpiResid {
    static constexpr bool PERM = false, RAW_I32 = false;
    const float* base; float* out;
    __device__ __forceinline__ void operator()(const f32x4 (&acc)[2][2][4][2], const Unit& u, int wr, int wc, int fr, int fq) const {
        const int row0 = u.pm * BM + wr * 64 + fr, col0 = u.pn * BM + wc * 32 + 4 * fq;
        EPI_ROWLOOP { const size_t off = (size_t)(row0 + ai * HALF + m * 16) * 1024 + col0;
#pragma unroll
            for (int bj = 0; bj < 2; ++bj)
#pragma unroll
                for (int n = 0; n < 2; ++n) { const f32x4 bs = *(const f32x4*)(base + off + bj * HALF + n * 16); *(f32x4*)(out + off + bj * HALF + n * 16) = bs + acc[ai][bj][m][n]; } }
    }
};
struct EpiPle {
    static constexpr bool PERM = true, RAW_I32 = false; static constexpr float QS = 1.0f / (QA_HN * QW_1024);
    unsigned char* out; const unsigned char* pp;
    __device__ __forceinline__ void operator()(const f32x4 (&acc)[2][2][4][2], const Unit& u, int wr, int wc, int fr, int fq) const {
        const int row0 = u.pm * BM + wr * 64 + fr, col0 = u.pn * BM + wc * 32 + 8 * fq;
        u32x2 ppv[2][4][2];
#pragma unroll
        for (int ai = 0; ai < 2; ++ai)
#pragma unroll
            for (int m = 0; m < 4; ++m)
#pragma unroll
                for (int bj = 0; bj < 2; ++bj) ppv[ai][m][bj] = *(const u32x2*)(pp + (size_t)(row0 + ai * HALF + m * 16) * 1024 + col0 + bj * HALF);
        EPI_ROWLOOP { const size_t off = (size_t)(row0 + ai * HALF + m * 16) * 1024 + col0;
#pragma unroll
            for (int bj = 0; bj < 2; ++bj) { const size_t o = off + bj * HALF; const u32x2 pw = ppv[ai][m][bj];
#define PP_B(w, k) ((float)(int)(signed char)((w) >> (8 * (k))))
                const f32x4 a0 = acc[ai][bj][m][0], a1 = acc[ai][bj][m][1];
                const f32x2 ip = {QA_T / QA_PP, QA_T / QA_PP};
                const f32x2 t0 = (sigmoid_s2((f32x2){a0[0], a0[1]}, QS) * ip) * (f32x2){PP_B(pw.x, 0), PP_B(pw.x, 1)}, t1 = (sigmoid_s2((f32x2){a0[2], a0[3]}, QS) * ip) * (f32x2){PP_B(pw.x, 2), PP_B(pw.x, 3)};
                const f32x2 t2 = (sigmoid_s2((f32x2){a1[0], a1[1]}, QS) * ip) * (f32x2){PP_B(pw.y, 0), PP_B(pw.y, 1)}, t3 = (sigmoid_s2((f32x2){a1[2], a1[3]}, QS) * ip) * (f32x2){PP_B(pw.y, 2), PP_B(pw.y, 3)};
#undef PP_B
                u32x2 ow; ow.x = pack4_i8((f32x4){t0[0], t0[1], t1[0], t1[1]}); ow.y = pack4_i8((f32x4){t2[0], t2[1], t3[0], t3[1]});
                *(u32x2*)(out + o) = ow; } }
    }
};
struct EpiRetIn {
    static constexpr bool PERM = true, RAW_I32 = false;
    unsigned char* Q; unsigned char* Kk; bf16_t* G; const float* cs; const float* sn; float qs;
    __device__ __forceinline__ void operator()(const f32x4 (&acc)[2][2][4][2], const Unit& u, int wr, int wc, int fr, int fq) const {
        const int row0 = u.pm * BM + wr * 64 + fr;
        if (u.pn < 8) {
            const int hd = u.pn & 3; unsigned char* dst = (u.pn < 4) ? Q : Kk; const float sc = QA_QK * qs;
            const int j0 = wc * 32 + 8 * fq;
#pragma unroll
            for (int ai = 0; ai < 2; ++ai) { f32x4 tc[4][2], ts[4][2];
#pragma unroll
              for (int m = 0; m < 4; ++m) { const int s = (row0 + ai * HALF + m * 16) & 2047;
                  tc[m][0] = *(const f32x4*)(cs + s * 128 + j0); tc[m][1] = *(const f32x4*)(cs + s * 128 + j0 + 4); ts[m][0] = *(const f32x4*)(sn + s * 128 + j0); ts[m][1] = *(const f32x4*)(sn + s * 128 + j0 + 4); }
#pragma unroll
              for (int m = 0; m < 4; ++m) { const int row = row0 + ai * HALF + m * 16, b = row >> 11, s = row & 2047;
                const f32x4 c0 = tc[m][0], c1 = tc[m][1], s0 = ts[m][0], s1 = ts[m][1];
                const f32x4 x10 = acc[ai][0][m][0], x11 = acc[ai][0][m][1], x20 = acc[ai][1][m][0], x21 = acc[ai][1][m][1];
                const f32x4 o10 = (x10 * c0 - x20 * s0) * sc, o11 = (x11 * c1 - x21 * s1) * sc, o20 = (x10 * s0 + x20 * c0) * sc, o21 = (x11 * s1 + x21 * c1) * sc;
                unsigned char* rowp = dst + ((size_t)(b * 4 + hd) * 2048 + s) * 256 + j0;
                u32x2 w1, w2;
                w1.x = pack4_i8(o10); w1.y = pack4_i8(o11); w2.x = pack4_i8(o20); w2.y = pack4_i8(o21);
                *(u32x2*)rowp = w1; *(u32x2*)(rowp + 128) = w2; } }
        } else {
            const int col0 = (u.pn - 8) * BM + wc * 32 + 8 * fq;
            EPI_ROWLOOP { bf16_t* rowp = G + (size_t)(row0 + ai * HALF + m * 16) * 2048 + col0;
#pragma unroll
                for (int bj = 0; bj < 2; ++bj) { u32x4 ow;
#pragma unroll
                    for (int n = 0; n < 2; ++n) { const f32x4 a = acc[ai][bj][m][n];
                        const f32x2 x0 = {a[0], a[1]}, x1 = {a[2], a[3]};
                        const f32x2 r0 = (x0 * (f32x2){qs, qs}) * sigmoid_s2(x0, qs), r1 = (x1 * (f32x2){qs, qs}) * sigmoid_s2(x1, qs);
                        const unsigned w0 = cvt_pk_bf16(r0[0], r0[1]), w1 = cvt_pk_bf16(r1[0], r1[1]);
                        if (n == 0) { ow.x = w0; ow.y = w1; } else { ow.z = w0; ow.w = w1; } }
                    *(u32x4*)(rowp + bj * HALF) = ow; } }
        }
    }
};
struct EpiVT {
    static constexpr bool PERM = true, RAW_I32 = false;
    bf16_t* VT; float qs;
    __device__ __forceinline__ void operator()(const f32x4 (&acc)[2][2][4][2], const Unit& u, int wr, int wc, int fr, int fq) const {
        const int row0 = u.pm * BM + wr * 64 + fr, col0 = u.pn * BM + wc * 32 + 8 * fq;
        const int b = col0 >> 11, s0 = col0 & 2047;
        EPI_ROWLOOP { const int R = row0 + ai * HALF + m * 16, hd = R >> 9, dv = R & 511;
#pragma unroll
            for (int bj = 0; bj < 2; ++bj) { const int s = s0 + bj * HALF;
                *(u32x4*)(VT + (((size_t)(b * 4 + hd) * 64 + (s >> 5)) * 512 + dv) * 32 + (s & 31)) = pack8(acc[ai][bj][m][0] * qs, acc[ai][bj][m][1] * qs); } }
    }
};
#undef EPI_ROWLOOP
}

struct Args {
    const float* x; const float* p; const float* norm_mix; const float* norm_ffn; const float* norm_ple; const float* final_norm;
    const float* conv_w_in; const float* conv_w; const float* conv_b; const float* conv_w_out;
    const float* ret_w_in; const float* ret_log_decay; const float* ret_w_out; const float* router_w;
    const float* exp_w_gate; const float* exp_w_up; const float* exp_w_down; const float* ple_w_proj; const float* ple_w_gate;
    float* out; unsigned char* ws; int ph_lo, ph_hi;
};
struct Frame {
    LAS unsigned char* lds; int tid, lane, wave, G, vcu, gw, NGW;
};

__device__ __forceinline__ void transpose_item(const float* W, int K, int N, bf16* WT, int k0, int n0, int drow0, LAS float* scr, int lane) {
#pragma unroll 8
    for (int i = 0; i < 32; ++i) { const int kk = 2 * i + (lane >> 5); scr[kk * 33 + (lane & 31)] = W[(size_t)(k0 + kk) * N + n0 + (lane & 31)]; }
    LDS_WAIT(); asm volatile("" ::: "memory");
    const int c = lane & 7;
#pragma unroll
    for (int j = 0; j < 4; ++j) { const int n = (lane >> 3) + 8 * j; const LAS float* s = scr + (8 * c) * 33 + n;
        v4u o; o.x = pk2(s[0 * 33], s[1 * 33]); o.y = pk2(s[2 * 33], s[3 * 33]); o.z = pk2(s[4 * 33], s[5 * 33]); o.w = pk2(s[6 * 33], s[7 * 33]);
        *(GAS v4u*)(WT + (size_t)(drow0 + n) * K + k0 + 8 * c) = o; }
    LDS_WAIT(); asm volatile("" ::: "memory");
}
using pg8::q8;
__device__ __forceinline__ void transpose_item_i8(const float* W, int K, int N, unsigned char* WT, int k0, int n0, int drow0, float qscale, LAS float* scr, int lane) {
#pragma unroll 8
    for (int i = 0; i < 32; ++i) { const int kk = 2 * i + (lane >> 5); scr[kk * 33 + (lane & 31)] = W[(size_t)(k0 + kk) * N + n0 + (lane & 31)]; }
    LDS_WAIT(); asm volatile("" ::: "memory");
    const int c = lane & 7;
#pragma unroll
    for (int j = 0; j < 4; ++j) { const int n = (lane >> 3) + 8 * j; const LAS float* s = scr + (8 * c) * 33 + n;
        v2u o; o.x = pg8::pack4_i8((f32x4){s[0 * 33], s[1 * 33], s[2 * 33], s[3 * 33]} * qscale);
        o.y = pg8::pack4_i8((f32x4){s[4 * 33], s[5 * 33], s[6 * 33], s[7 * 33]} * qscale);
        *(GAS v2u*)(WT + (size_t)(drow0 + n) * K + k0 + 8 * c) = o; }
    LDS_WAIT(); asm volatile("" ::: "memory");
}
__device__ __forceinline__ void transpose_item_f8(const float* W, int K, int N, unsigned char* WT, int k0, int n0, int drow0, float qscale, LAS float* scr, int lane) {
#pragma unroll 8
    for (int i = 0; i < 32; ++i) { const int kk = 2 * i + (lane >> 5); scr[kk * 33 + (lane & 31)] = W[(size_t)(k0 + kk) * N + n0 + (lane & 31)]; }
    LDS_WAIT(); asm volatile("" ::: "memory");
    const int c = lane & 7;
#pragma unroll
    for (int j = 0; j < 4; ++j) { const int n = (lane >> 3) + 8 * j; const LAS float* s = scr + (8 * c) * 33 + n;
        v2u o; int t_ = 0;
        t_ = __builtin_amdgcn_cvt_pk_fp8_f32(pg8::clamp_f8(s[0 * 33] * qscale), pg8::clamp_f8(s[1 * 33] * qscale), t_, false); t_ = __builtin_amdgcn_cvt_pk_fp8_f32(pg8::clamp_f8(s[2 * 33] * qscale), pg8::clamp_f8(s[3 * 33] * qscale), t_, true); o.x = (unsigned)t_;
        t_ = __builtin_amdgcn_cvt_pk_fp8_f32(pg8::clamp_f8(s[4 * 33] * qscale), pg8::clamp_f8(s[5 * 33] * qscale), t_, false); t_ = __builtin_amdgcn_cvt_pk_fp8_f32(pg8::clamp_f8(s[6 * 33] * qscale), pg8::clamp_f8(s[7 * 33] * qscale), t_, true); o.y = (unsigned)t_;
        *(GAS v2u*)(WT + (size_t)(drow0 + n) * K + k0 + 8 * c) = o; }
    LDS_WAIT(); asm volatile("" ::: "memory");
}
template <int MAP  >
__device__ __forceinline__ void transpose_matrix(const Frame& F, const float* W, int K, int N, bf16* WT, LAS float* scr) {
    const int nblk = N / 32, nitems = (K / 64) * nblk;
    for (int it = F.gw; it < nitems; it += F.NGW) {
        const int kb = it / nblk, nb = it % nblk, n0 = 32 * nb; int drow0 = n0;
        if (MAP == 1 || MAP == 8) { if (n0 >= 1024) { const int v = (n0 >= 2048) ? 1 : 0, d = n0 - 1024 - 1024 * v; drow0 = 1024 + 256 * (d >> 7) + 128 * v + (d & 127); } }
        if (MAP == 2) drow0 = 256 * (n0 >> 7) + (n0 & 127);
        if (MAP == 3) drow0 = 256 * (n0 >> 7) + 128 + (n0 & 127);
        if (MAP == 4 || MAP == 7) { if (n0 >= 4096) drow0 = n0 - 2048; else if (n0 >= 2048) drow0 = n0 + 2048; }
        if (MAP == 5) transpose_item_i8(W, K, N, (unsigned char*)WT, 64 * kb, n0, drow0, QW_2048, scr, F.lane);
        else if (MAP == 6 || MAP == 7 || MAP == 8) transpose_item_i8(W, K, N, (unsigned char*)WT, 64 * kb, n0, drow0, QW_1024, scr, F.lane);
        else if (MAP == 2 || MAP == 3) transpose_item_i8(W, K, N, (unsigned char*)WT, 64 * kb, n0, drow0, QW_1024, scr, F.lane);
        else transpose_item(W, K, N, WT, 64 * kb, n0, drow0, scr, F.lane);
    }
}
__device__ __forceinline__ void convert_experts(const Frame& F, const Args& a, int layer, LAS float* scr) {
    bf16* we1 = (bf16*)(a.ws + WS_WE1); bf16* we2 = (bf16*)(a.ws + WS_WE2);
    for (int e = 0; e < NE; ++e) {
        const size_t wofs = ((size_t)layer * NE + e) * (size_t)D * FF;
        transpose_matrix<2>(F, a.exp_w_gate + wofs, D, FF, we1 + (size_t)e * 4096 * (D / 2), scr);
        transpose_matrix<3>(F, a.exp_w_up + wofs, D, FF, we1 + (size_t)e * 4096 * (D / 2), scr);
        transpose_matrix<5>(F, a.exp_w_down + wofs, FF, D, we2 + (size_t)e * D * (FF / 2), scr);
    }
}

using pg8::q8;
__device__ __forceinline__ void load_row(const float* xrow, int lane, f32x4 (&v)[4]) {
    const GAS f32x4* xr = (const GAS f32x4*)xrow + lane;
#pragma unroll
    for (int j = 0; j < 4; ++j) v[j] = xr[64 * j];
}
__device__ __forceinline__ float row_rs(const f32x4 (&v)[4]) {
    float s = 0.f;
#pragma unroll
    for (int j = 0; j < 4; ++j) s += (v[j].x * v[j].x + v[j].y * v[j].y) + (v[j].z * v[j].z + v[j].w * v[j].w);
    return 1.0f / sqrtf(wave_sum(s) * (1.f / D) + NORM_EPS);
}
__device__ __forceinline__ void store_row_bf16(bf16* orow, int lane, const f32x4 (&v)[4]) {
    GAS unsigned long long* o8 = (GAS unsigned long long*)orow + lane;
#pragma unroll
    for (int j = 0; j < 4; ++j) o8[64 * j] = (unsigned long long)pk2(v[j].x, v[j].y) | ((unsigned long long)pk2(v[j].z, v[j].w) << 32);
}
__device__ __forceinline__ void load_row_bf16(const bf16* hrow, int lane, f32x4 (&v)[4]) {
    const GAS unsigned long long* hr = (const GAS unsigned long long*)hrow + lane;
#pragma unroll
    for (int j = 0; j < 4; ++j) { const unsigned long long w = hr[64 * j]; const unsigned lo = (unsigned)w, hi = (unsigned)(w >> 32);
        v[j].x = pg8::bf_lo(lo); v[j].y = pg8::bf_hi(lo); v[j].z = pg8::bf_lo(hi); v[j].w = pg8::bf_hi(hi); }
}
__device__ __forceinline__ void add_delta_row(const bf16* drow, int lane, f32x4 (&v)[4]) {
    const GAS unsigned long long* dr = (const GAS unsigned long long*)drow + lane;
#pragma unroll
    for (int j = 0; j < 4; ++j) { const unsigned long long w = dr[64 * j]; const unsigned lo = (unsigned)w, hi = (unsigned)(w >> 32);
        v[j].x += pg8::bf_lo(lo); v[j].y += pg8::bf_hi(lo); v[j].z += pg8::bf_lo(hi); v[j].w += pg8::bf_hi(hi); }
}
__device__ __forceinline__ void add_delta_row_i8(const unsigned char* drow, int lane, f32x4 (&v)[4], float inv) {
    const GAS unsigned* dr = (const GAS unsigned*)drow + lane;
#pragma unroll
    for (int j = 0; j < 4; ++j) { const unsigned w = dr[64 * j];
        v[j] = (f32x4){(float)(int)(signed char)w, (float)(int)(signed char)(w >> 8), (float)(int)(signed char)(w >> 16), (float)((int)w >> 24)} * inv + v[j]; }
}
__device__ __forceinline__ void store_row_f32(float* orow, int lane, const f32x4 (&v)[4]) {
    GAS f32x4* o = (GAS f32x4*)orow + lane;
#pragma unroll
    for (int j = 0; j < 4; ++j) o[64 * j] = v[j];
}
__device__ __forceinline__ void norm_rows_phase(const Frame& F, const float* src, bf16* h16, const bf16* delta, const float* gain, bf16* dst, bool i8out = false) {
    f32x4 g[4]; load_row(gain, F.lane, g);
    for (int m = F.gw; m < T; m += F.NGW) {
        f32x4 v[4];
        if (src) load_row(src + (size_t)m * D, F.lane, v);
        else { load_row_bf16(h16 + (size_t)m * D, F.lane, v); add_delta_row_i8((const unsigned char*)delta + (size_t)m * D, F.lane, v, 1.0f / QA_T); store_row_bf16(h16 + (size_t)m * D, F.lane, v); }
        const float rs = row_rs(v);
#pragma unroll
        for (int j = 0; j < 4; ++j) v[j] = v[j] * rs * g[j];
        if (i8out) { GAS unsigned* o4 = (GAS unsigned*)((unsigned char*)dst + (size_t)m * D) + F.lane;
#pragma unroll
            for (int jj = 0; jj < 4; ++jj) o4[64 * jj] = pg8::pack4_i8(v[jj] * QA_HN); }
        else store_row_bf16(dst + (size_t)m * D, F.lane, v);
    }
}
__device__ __forceinline__ void final_rows_phase(const Frame& F, float* h, const bf16* h16, const bf16* delta, const float* gain) {
    f32x4 g[4]; load_row(gain, F.lane, g);
    for (int m = F.gw; m < T; m += F.NGW) {
        f32x4 v[4]; load_row_bf16(h16 + (size_t)m * D, F.lane, v); add_delta_row_i8((const unsigned char*)delta + (size_t)m * D, F.lane, v, 1.0f / QA_T); const float rs = row_rs(v);
        GAS f32x4* o = (GAS f32x4*)(h + (size_t)m * D) + F.lane;
#pragma unroll
        for (int j = 0; j < 4; ++j) o[64 * j] = v[j] * rs * g[j];
    }
}
__device__ __forceinline__ void rope_table_phase(const Frame& F, float* cs, float* sn) {
    for (int i = (F.vcu * NTHREADS + F.tid); i < SEQ * 128; i += F.G * NTHREADS) {
        const int pos = i >> 7, j = i & 127;
        const float inv = exp2f(-(float)j * (13.287712379549449f / 128.0f));
        const float ang = (float)pos * inv;
        const double a = (double)ang; const double n = rint(a * 0.63661977236758134);
        const double r = __builtin_fma(-n, 1.5707963267948966, a) - n * 6.123233995736766e-17;
        const double r2 = r * r;
        const double sr = r * (1.0 - r2 / 6.0 * (1.0 - r2 / 20.0 * (1.0 - r2 / 42.0 * (1.0 - r2 / 72.0 * (1.0 - r2 / 110.0 * (1.0 - r2 / 156.0))))));
        const double cr = 1.0 - r2 / 2.0 * (1.0 - r2 / 12.0 * (1.0 - r2 / 30.0 * (1.0 - r2 / 56.0 * (1.0 - r2 / 90.0 * (1.0 - r2 / 132.0 * (1.0 - r2 / 182.0))))));
        const int q = ((int)n) & 3;
        const double s_ = (q == 0) ? sr : (q == 1) ? cr : (q == 2) ? -sr : -cr;
        const double c_ = (q == 0) ? cr : (q == 1) ? -sr : (q == 2) ? -cr : sr;
        cs[i] = (float)c_; sn[i] = (float)s_;
    }
}
__device__ __forceinline__ void conv_phase(const Frame& F, const bf16* Bb, const bf16* Ub, bf16* Zb, const float* cw, const float* cb) {
    const int cg = F.tid & 127, tsub = F.tid >> 7, c0 = cg * 8;
    float w0[8], w1[8], w2[8], bi[8];
#pragma unroll
    for (int e = 0; e < 8; ++e) { w0[e] = cw[c0 + e]; w1[e] = cw[D + c0 + e]; w2[e] = cw[2 * D + c0 + e]; bi[e] = cb[c0 + e]; }
    for (int t = F.vcu * 4 + tsub; t < T; t += F.G * 4) {
        const int s = t & (SEQ - 1);
        const v4u zero = (v4u){0u, 0u, 0u, 0u};
        const v4u um = (s > 0) ? *(const GAS v4u*)(Ub + (size_t)(t - 1) * D + c0) : zero;
        const v4u u0 = *(const GAS v4u*)(Ub + (size_t)t * D + c0);
        const v4u up = (s < SEQ - 1) ? *(const GAS v4u*)(Ub + (size_t)(t + 1) * D + c0) : zero;
        const v4u bb = *(const GAS v4u*)(Bb + (size_t)t * D + c0);
        float z[8];
#pragma unroll
        for (int e2 = 0; e2 < 4; ++e2) {
            const unsigned a = um[e2], b = u0[e2], c = up[e2], g = bb[e2];
            z[2 * e2] = pg8::bf_lo(g) * (w0[2 * e2] * pg8::bf_lo(a) + w1[2 * e2] * pg8::bf_lo(b) + w2[2 * e2] * pg8::bf_lo(c) + bi[2 * e2]);
            z[2 * e2 + 1] = pg8::bf_hi(g) * (w0[2 * e2 + 1] * pg8::bf_hi(a) + w1[2 * e2 + 1] * pg8::bf_hi(b) + w2[2 * e2 + 1] * pg8::bf_hi(c) + bi[2 * e2 + 1]);
        }
        v4u o; o.x = pk2(z[0], z[1]); o.y = pk2(z[2], z[3]); o.z = pk2(z[4], z[5]); o.w = pk2(z[6], z[7]);
        *(GAS v4u*)(Zb + (size_t)t * D + c0) = o;
    }
}
__device__ __forceinline__ void convert_p_phase(const Frame& F, const float* p, bf16* pb) {
    const size_t n8 = (size_t)T * PLE / 8;
    for (size_t i = (size_t)F.vcu * NTHREADS + F.tid; i < n8; i += (size_t)F.G * NTHREADS) {
        const f32x4 a = *(const GAS f32x4*)(p + i * 8), b = *(const GAS f32x4*)(p + i * 8 + 4);
        v4u o; o.x = pk2(a.x, a.y); o.y = pk2(a.z, a.w); o.z = pk2(b.x, b.y); o.w = pk2(b.z, b.w);
        *(GAS v4u*)(pb + i * 8) = o;
    }
}
__device__ __forceinline__ float xchg_reduce(float keep, float send, int x) { return keep + __shfl_xor(send, x); }
__device__ __forceinline__ void router_phase(const Frame& F, const float* xin  , const bf16* delta, bf16* h16, const float* gain, const float* rw, bf16* hn, float* aff) {
    LAS float* rwl = (LAS float*)(F.lds + RING_OFF);
    for (int i = F.tid; i < D * NE; i += NTHREADS) { const int c = i >> 4, e = i & 15; rwl[e * D + c] = rw[i]; }
    __syncthreads();
    f32x4 g[4]; load_row(gain, F.lane, g);
    const int lane = F.lane;
    for (int m = F.gw; m < T; m += F.NGW) {
        asm volatile("" ::: "memory");
        f32x4 v[4]; if (xin) load_row(xin + (size_t)m * D, lane, v); else load_row_bf16(h16 + (size_t)m * D, lane, v);
        add_delta_row(delta + (size_t)m * D, lane, v); store_row_bf16(h16 + (size_t)m * D, lane, v);
        const float rs = row_rs(v);
#pragma unroll
        for (int j = 0; j < 4; ++j) v[j] = v[j] * rs * g[j];
        { GAS unsigned* o4 = (GAS unsigned*)((unsigned char*)hn + (size_t)m * D) + lane;
#pragma unroll
          for (int j = 0; j < 4; ++j) o4[64 * j] = pg8::pack4_i8(v[j] * QA_HN); }
        float lg[NE];
#pragma unroll
        for (int e = 0; e < NE; ++e) { float acc = 0.f;
#pragma unroll
            for (int j = 0; j < 4; ++j) { const f32x4 w = *(const LAS f32x4*)(rwl + e * D + 256 * j + 4 * lane); acc += v[j].x * w.x + v[j].y * w.y + v[j].z * w.z + v[j].w * w.w; }
            lg[e] = acc; }
        float r8[8], r4[4], r2[2], r1;
        { const bool up = (lane & 32) != 0;
#pragma unroll
          for (int i = 0; i < 8; ++i) r8[i] = xchg_reduce(up ? lg[8 + i] : lg[i], up ? lg[i] : lg[8 + i], 32); }
        { const bool up = (lane & 16) != 0;
#pragma unroll
          for (int i = 0; i < 4; ++i) r4[i] = xchg_reduce(up ? r8[4 + i] : r8[i], up ? r8[i] : r8[4 + i], 16); }
        { const bool up = (lane & 8) != 0;
#pragma unroll
          for (int i = 0; i < 2; ++i) r2[i] = xchg_reduce(up ? r4[2 + i] : r4[i], up ? r4[i] : r4[2 + i], 8); }
        { const bool up = (lane & 4) != 0; r1 = xchg_reduce(up ? r2[1] : r2[0], up ? r2[0] : r2[1], 4); }
        r1 += __shfl_xor(r1, 2); r1 += __shfl_xor(r1, 1);
        float mx = r1;
#pragma unroll
        for (int o = 4; o < 64; o <<= 1) mx = fmaxf(mx, __shfl_xor(mx, o));
        const float ex = expf(r1 - mx); float den = ex;
#pragma unroll
        for (int o = 4; o < 64; o <<= 1) den += __shfl_xor(den, o);
        const int e = ((lane >> 5) & 1) * 8 + ((lane >> 4) & 1) * 4 + ((lane >> 3) & 1) * 2 + ((lane >> 2) & 1);
        const int b = m >> 11, sq = m & (SEQ - 1);
        if ((lane & 3) == 0) aff[((size_t)b * NE + e) * SEQ + sq] = ex / den;
    }
    __syncthreads();
}
__device__ __forceinline__ void topk_phase(const Frame& F, const float* aff, int* tok, float* gate, int* inv) {
    LAS unsigned* cw = (LAS unsigned*)(F.lds + RING_OFF);
    LAS unsigned* pg = cw + 16;
    LAS unsigned* pe = pg + 32;
    const int w = F.wave, lane = F.lane;
    for (int item = F.vcu; item < BATCH * NE; item += F.G) {
        const int b = item / NE, e = item % NE;
        const float* src = aff + (size_t)item * SEQ;
        unsigned xv[4];
#pragma unroll
        for (int j = 0; j < 4; ++j) xv[j] = __float_as_uint(src[F.tid + NTHREADS * j]);
        unsigned thr = 0u;
        __syncthreads();
#pragma unroll 1
        for (int bit = 30; bit >= 0; --bit) {
            const unsigned cand = thr | (1u << bit);
            unsigned c = 0;
#pragma unroll
            for (int j = 0; j < 4; ++j) c += (unsigned)__popcll(__ballot(xv[j] >= cand));
            LAS unsigned* slot = cw + (bit & 1) * 8;
            if (lane == 0) slot[w] = c;
            __syncthreads();
            unsigned tot = 0;
#pragma unroll
            for (int ww = 0; ww < 8; ++ww) tot += slot[ww];
            if (tot >= (unsigned)CAP) thr = cand;
        }
        unsigned long long mg[4], me[4];
#pragma unroll
        for (int j = 0; j < 4; ++j) { mg[j] = __ballot(xv[j] > thr); me[j] = __ballot(xv[j] == thr);
            if (lane == 0) { pg[j * 8 + w] = (unsigned)__popcll(mg[j]); pe[j * 8 + w] = (unsigned)__popcll(me[j]); } }
        __syncthreads();
        unsigned totg = 0;
#pragma unroll
        for (int i = 0; i < 32; ++i) totg += pg[i];
        const unsigned long long below = (1ull << lane) - 1ull;
#pragma unroll
        for (int j = 0; j < 4; ++j) {
            unsigned bg = 0, be = 0;
            for (int i = 0; i < j * 8 + w; ++i) { bg += pg[i]; be += pe[i]; }
            const unsigned rg = bg + (unsigned)__popcll(mg[j] & below), re = be + (unsigned)__popcll(me[j] & below);
            const int me_i = F.tid + NTHREADS * j;
            int slot = -1;
            if (xv[j] > thr) slot = (int)rg; else if (xv[j] == thr && totg + re < (unsigned)CAP) slot = (int)(totg + re);
            if (slot >= 0) { const size_t o = ((size_t)e * BATCH + b) * CAP + slot; tok[o] = me_i; gate[o] = __uint_as_float(xv[j]); }
            inv[((size_t)b * SEQ + me_i) * NE + e] = slot;
        }
    }
    __syncthreads();
}
__device__ __forceinline__ void combine_phase(const Frame& F, bf16* h16, const bf16* Y, const int* inv, const float* gain, bf16* hb) {
    f32x4 g[4]; load_row(gain, F.lane, g);
    int inv_next = (F.lane < NE && F.gw < T) ? inv[(size_t)F.gw * NE + F.lane] : -1;
    for (int m = F.gw; m < T; m += F.NGW) {
        const int b = m >> 11;
        const int myinv = inv_next;
        { const int mn = m + F.NGW; inv_next = (F.lane < NE && mn < T) ? inv[(size_t)mn * NE + F.lane] : -1; }
        f32x4 v[4]; load_row_bf16(h16 + (size_t)m * D, F.lane, v);
        unsigned mk = (unsigned)__ballot(myinv >= 0) & 0xffffu;
        const unsigned e0 = mk ? (unsigned)__builtin_ctz(mk) : 0u;
        unsigned long long yv[4][4]; float wk[4];
#pragma unroll
        for (int k = 0; k < 4; ++k) {
            const bool have = mk != 0u; const unsigned e = have ? (unsigned)__builtin_ctz(mk) : e0; if (have) mk &= mk - 1u;
            int slot = __builtin_amdgcn_readlane(myinv, (int)e); if (slot < 0) slot = 0;
            wk[k] = have ? 1.0f : 0.0f;
            const GAS unsigned long long* yr = (const GAS unsigned long long*)(Y + (((size_t)e * BATCH + b) * CAP + slot) * D) + F.lane;
#pragma unroll
            for (int j = 0; j < 4; ++j) yv[k][j] = yr[64 * j];
        }
#pragma unroll
        for (int k = 0; k < 4; ++k)
#pragma unroll
            for (int j = 0; j < 4; ++j) { const unsigned lo = (unsigned)yv[k][j], hi = (unsigned)(yv[k][j] >> 32);
                v[j].x += wk[k] * pg8::bf_lo(lo); v[j].y += wk[k] * pg8::bf_hi(lo); v[j].z += wk[k] * pg8::bf_lo(hi); v[j].w += wk[k] * pg8::bf_hi(hi); }
        while (mk) {
            const unsigned e = (unsigned)__builtin_ctz(mk); mk &= mk - 1u;
            const int slot = __builtin_amdgcn_readlane(myinv, (int)e);
            const GAS unsigned long long* yr = (const GAS unsigned long long*)(Y + (((size_t)e * BATCH + b) * CAP + slot) * D) + F.lane;
#pragma unroll
            for (int j = 0; j < 4; ++j) { const unsigned long long w = yr[64 * j]; const unsigned lo = (unsigned)w, hi = (unsigned)(w >> 32);
                v[j].x += pg8::bf_lo(lo); v[j].y += pg8::bf_hi(lo); v[j].z += pg8::bf_lo(hi); v[j].w += pg8::bf_hi(hi); }
        }
        store_row_bf16(h16 + (size_t)m * D, F.lane, v);
        const float rs = row_rs(v);
#pragma unroll
        for (int j = 0; j < 4; ++j) v[j] = v[j] * rs * g[j];
        { GAS unsigned* o4 = (GAS unsigned*)((unsigned char*)hb + (size_t)m * D) + F.lane;
#pragma unroll
          for (int jj = 0; jj < 4; ++jj) o4[64 * jj] = pg8::pack4_i8(v[jj] * QA_HN); }
    }
}

namespace ret {
using pg8::i32x4; using pg8::f32x2;
typedef unsigned u32x4 __attribute__((ext_vector_type(4)));
typedef unsigned u32x2 __attribute__((ext_vector_type(2)));
constexpr int KROW = 288  , KBUF = 9216, PROW = 80, PBUF = 10240;
constexpr float QK_LSC = -14.0f;
constexpr int K_OFF = 0, P_OFF = 2 * KBUF, ST1_OFF = P_OFF + 2 * PBUF, ST2_OFF = ST1_OFF + 8192, RET_LDS_END = ST2_OFF + 1024;
static_assert(RET_LDS_END <= LDS_BYTES - 512, "retention LDS map");
constexpr int NCHUNK = SEQ / 32;

__device__ __forceinline__ void retention_phase(const Frame& F, const unsigned char* Q, const unsigned char* Kk, const bf16* VT, const bf16* G, unsigned char* O8, const float* logdecay, bool do_store) {
    LAS unsigned char* lds = F.lds;
    const int w = F.wave;
    int lane_ = F.lane; asm volatile("" : "+v"(lane_)); const int lane = lane_;
    unsigned offK[2];
#pragma unroll
    for (int k = 0; k < 2; ++k) { const int ci = 64 * (w + 8 * k) + lane; int row = ci / 18, cc = ci % 18; if (row > 31) row = 31; if (cc >= 16) cc = 0; offK[k] = (unsigned)(row * 256 + cc * 16); }
    const int cq = lane & 15, q4 = lane >> 4, r = lane & 31, hf = lane >> 5;
    const unsigned voff = (unsigned)((64 * w + r) * 64 + 16 * hf);

    for (int unit = F.vcu; unit < BATCH * RH * 16; unit += F.G) {
        const int bh = unit >> 4, qt = unit & 15, b = bh >> 2, hd = bh & 3;
        const char* kg = (const char*)(Kk + (size_t)bh * SEQ * RQK);
        const char* vg = (const char*)(VT + (size_t)bh * RV * SEQ);
        const float lf2 = logdecay[hd] * 1.44269504089f, lb2 = logdecay[4 + hd] * 1.44269504089f;
#define RET_DMA_K(c, buf) do { \
        _Pragma("unroll") for (int k = 0; k < 2; ++k) if (w + 8 * k < 9) { unsigned o_ = offK[k]; asm volatile("" : "+v"(o_)); \
            __builtin_amdgcn_global_load_lds((const unsigned*)(kg + (size_t)(c) * (32 * 256) + o_), (LAS unsigned*)(lds + K_OFF + (buf) * KBUF + (w + 8 * k) * 1024), 16, 0, 0); } } while (0)
  \
#define RET_LD_V(c, dst) do { unsigned o_ = voff; asm volatile("" : "+v"(o_)); const char* vp_ = vg + (size_t)(c) * 32768 + o_; \
        asm volatile("global_load_dwordx4 %0, %1, off" : "=v"(dst[0][0]) : "v"(vp_)); asm volatile("global_load_dwordx4 %0, %1, off offset:32" : "=v"(dst[0][1]) : "v"(vp_)); \
        asm volatile("global_load_dwordx4 %0, %1, off offset:2048" : "=v"(dst[1][0]) : "v"(vp_)); asm volatile("global_load_dwordx4 %0, %1, off offset:2080" : "=v"(dst[1][1]) : "v"(vp_)); } while (0)
#define RET_S(c, buf) do { i32x4 sa_[2]; \
        _Pragma("unroll") for (int blk = 0; blk < 2; ++blk) { \
            i32x4 sacc = (i32x4){0, 0, 0, 0}; \
            const LAS unsigned char* kp = lds + K_OFF + (buf) * KBUF + (16 * blk + cq) * KROW + 16 * q4; \
            _Pragma("unroll") for (int s_ = 0; s_ < 4; ++s_) { const i32x4 kf = *(const LAS i32x4*)(kp + 64 * s_); sacc = __builtin_amdgcn_mfma_i32_16x16x64_i8(kf, qf[s_], sacc, 0, 0, 0); } \
            sa_[blk] = sacc; } \
          \
        _Pragma("unroll") for (int blk = 0; blk < 2; ++blk) { \
            const float fd0 = (float)(nq - (32 * (c) + 16 * blk + 4 * q4)); float pv[4]; \
              \
            _Pragma("unroll") for (int e = 0; e < 4; e += 2) { const f32x2 fd = (f32x2){fd0, fd0} - (f32x2){(float)e, (float)(e + 1)}; \
                const f32x2 xa = fd * (f32x2){lf2, lf2} + (f32x2){QK_LSC, QK_LSC}, xb = fd * (f32x2){-lb2, -lb2} + (f32x2){QK_LSC, QK_LSC}; \
                const f32x2 pw_ = (f32x2){(float)sa_[blk][e], (float)sa_[blk][e + 1]} * (f32x2){__builtin_amdgcn_exp2f(fminf(xa[0], xb[0])), __builtin_amdgcn_exp2f(fminf(xa[1], xb[1]))}; \
                pv[e] = pw_[0]; pv[e + 1] = pw_[1]; } \
            v2u pw; pw.x = pg8::cvt_pk_bf16(pv[0], pv[1]); pw.y = pg8::cvt_pk_bf16(pv[2], pv[3]); \
            *(LAS v2u*)(lds + P_OFF + (buf) * PBUF + (16 * w + cq) * PROW + (16 * blk + 4 * q4) * 2) = pw; } } while (0)
#define RET_PV(vr, pbuf) do { \
        _Pragma("unroll") for (int s_ = 0; s_ < 2; ++s_) { bf16x8 pf[4]; \
            _Pragma("unroll") for (int i = 0; i < 4; ++i) pf[i] = *(const LAS bf16x8*)(lds + P_OFF + (pbuf) * PBUF + (32 * i + r) * PROW + 32 * s_ + 16 * hf); \
            _Pragma("unroll") for (int jb = 0; jb < 2; ++jb) _Pragma("unroll") for (int i = 0; i < 4; ++i) OT[jb][i] = __builtin_amdgcn_mfma_f32_32x32x16_bf16(vr[jb][s_], pf[i], OT[jb][i], 0, 0, 0); } } while (0)
#define RET_TOP() do { VM_WAIT(); LDS_WAIT(); __builtin_amdgcn_s_barrier(); asm volatile("" ::: "memory"); } while (0)
        i32x4 qf[4];
        { const unsigned char* qrow = Q + ((size_t)bh * SEQ + qt * 128 + 16 * w + cq) * RQK + 16 * q4;
#pragma unroll
          for (int s = 0; s < 4; ++s) qf[s] = *(const GAS i32x4*)(qrow + 64 * s); }
        RET_DMA_K(0, 0);
        f32x16 OT[2][4];
#pragma unroll
        for (int jb = 0; jb < 2; ++jb)
#pragma unroll
            for (int i = 0; i < 4; ++i)
#pragma unroll
                for (int e = 0; e < 16; ++e) OT[jb][i][e] = 0.f;
        const int nq = qt * 128 + 16 * w + cq;
        bf16x8 v0[2][2], v1[2][2];
#define RET_SP_A(c, kb, vr, pb) do { RET_S(c, kb); RET_PV(vr, pb); } while (0)
#define RET_SP_B(c, kb, vr, pb) do { RET_PV(vr, pb); RET_S(c, kb); } while (0)
#define RET_SEQ(SP) do { \
          \
        RET_TOP(); RET_DMA_K(1, 1); RET_LD_V(0, v0); RET_S(0, 0); \
        _Pragma("unroll 1") for (int c = 1; c < NCHUNK - 1; c += 2) { \
              \
            RET_TOP(); RET_DMA_K(c + 1, 0); RET_LD_V(c, v1); SP(c, 1, v0, 0); \
              \
            RET_TOP(); RET_DMA_K(c + 2, 1); RET_LD_V(c + 1, v0); SP(c + 1, 0, v1, 1); \
        } \
          \
        RET_TOP(); RET_LD_V(NCHUNK - 1, v1); SP(NCHUNK - 1, 1, v0, 0); \
        RET_TOP(); RET_PV(v1, 1); } while (0)
        if (w < 4) RET_SEQ(RET_SP_A); else RET_SEQ(RET_SP_B);
#undef RET_SEQ
#undef RET_SP_A
#undef RET_SP_B
        LAS float* st1 = (LAS float*)(lds + ST1_OFF); LAS float* st2 = (LAS float*)(lds + ST2_OFF);
        u32x4 sgv[4][2][2];
        { int le_ = lane; asm volatile("" : "+v"(le_));
#pragma unroll
          for (int i = 0; i < 4; ++i) { const bf16* grow = G + ((size_t)b * SEQ + qt * 128 + 32 * i + (le_ & 31)) * RVW + hd * RV + 64 * w + 8 * (le_ >> 5);
#pragma unroll
            for (int jb = 0; jb < 2; ++jb)
#pragma unroll
                for (int ap = 0; ap < 2; ++ap) sgv[i][jb][ap] = *(const GAS u32x4*)(grow + 32 * jb + 16 * ap); } }
#pragma unroll
        for (int i = 0; i < 4; ++i) { float s1 = 0.f, s2 = 0.f;
#pragma unroll
            for (int jb = 0; jb < 2; ++jb)
#pragma unroll
                for (int e = 0; e < 16; ++e) { const float v = OT[jb][i][e]; s1 += v; s2 += v * v; }
            s1 += __shfl_xor(s1, 32); s2 += __shfl_xor(s2, 32);
            if (hf == 0) { st1[(w * 128 + 32 * i + r) * 2] = s1; st1[(w * 128 + 32 * i + r) * 2 + 1] = s2; } }
        LDS_WAIT(); __syncthreads();
        if (F.tid < 128) { float S1 = 0.f, S2 = 0.f;
#pragma unroll
            for (int ww = 0; ww < 8; ++ww) { S1 += st1[(ww * 128 + F.tid) * 2]; S2 += st1[(ww * 128 + F.tid) * 2 + 1]; }
            const float mean = S1 * (1.f / RV); const float var = fmaxf(S2 * (1.f / RV) - mean * mean, 0.f);
            st2[F.tid * 2] = mean; st2[F.tid * 2 + 1] = 1.0f / sqrtf(var + GN_EPS); }
        LDS_WAIT(); __syncthreads();
#pragma unroll
        for (int i = 0; i < 4; ++i) { const float mean = st2[(32 * i + r) * 2], rstd = st2[(32 * i + r) * 2 + 1]; const float rs = rstd * QA_OG, mb = -mean * rs;
            unsigned char* orow = O8 + ((size_t)b * SEQ + qt * 128 + 32 * i + r) * RVW + hd * RV + 64 * w + 8 * hf;
#pragma unroll
            for (int jb = 0; jb < 2; ++jb)
#pragma unroll
                for (int ap = 0; ap < 2; ++ap) { const u32x4 L = sgv[i][jb][ap];
                    const u32x2 sx = __builtin_amdgcn_permlane32_swap(L.x, L.z, false, false), sy = __builtin_amdgcn_permlane32_swap(L.y, L.w, false, false);
                    unsigned ow[2];
#pragma unroll
                    for (int q = 0; q < 2; ++q) { const int g4 = 2 * ap + q; const unsigned s0 = q ? sx.y : sx.x, s1 = q ? sy.y : sy.x;
                        const f32x4 ov = (f32x4){OT[jb][i][4 * g4 + 0], OT[jb][i][4 * g4 + 1], OT[jb][i][4 * g4 + 2], OT[jb][i][4 * g4 + 3]} * (f32x4){rs, rs, rs, rs} + (f32x4){mb, mb, mb, mb};
                        ow[q] = pg8::pack4_i8(ov * (f32x4){pg8::bf_lo(s0), pg8::bf_hi(s0), pg8::bf_lo(s1), pg8::bf_hi(s1)}); }
                    const u32x2 tx = __builtin_amdgcn_permlane32_swap(ow[0], ow[1], false, false);
                    v2u o8; o8.x = tx.x; o8.y = tx.y;
                    if (do_store) *(GAS v2u*)(orow + 32 * jb + 16 * ap) = o8; } }
        __syncthreads();
#undef RET_DMA_K
#undef RET_LD_V
#undef RET_S
#undef RET_PV
#undef RET_TOP
    }
}
}

constexpr int N_PHASES = 24;
__device__ __forceinline__ unsigned char* opq(unsigned char* p) { asm volatile("" : "+s"(p)); return p; }
__global__ void __launch_bounds__(NTHREADS, 2) enc_fwd(Args a) {
    extern __shared__ __attribute__((aligned(16))) unsigned char lds_raw[];
    Frame F;
    F.lds = (LAS unsigned char*)lds_raw;
    F.tid = threadIdx.x; F.lane = F.tid & 63; F.wave = __builtin_amdgcn_readfirstlane(F.tid >> 6);
    F.G = gridDim.x; { const int bx = blockIdx.x; F.vcu = (F.G % 8 == 0) ? (bx % 8) * (F.G / 8) + bx / 8 : bx; }
    F.gw = F.vcu * NWAVES + F.wave; F.NGW = F.G * NWAVES;
    volatile LAS unsigned* MISC = (volatile LAS unsigned*)(F.lds + MISC_OFF);
    for (int u = F.tid; u < (LDS_BYTES - MISC_OFF) / 4; u += NTHREADS) ((LAS unsigned*)(F.lds + MISC_OFF))[u] = 0u;
    __syncthreads();
    unsigned char* ws = a.ws;
    XcdBarrier bar = xcd_barrier_post((unsigned*)(ws + WS_CTL) + CW_BAR, MISC + 8);
    const int lo = a.ph_lo, hi = a.ph_hi;
#ifndef MK_MASK
#define MK_MASK 0xFFFFFFu
#endif
#define EN(k) (((MK_MASK) >> (k)) & 1u)
#define REP(k) for (int rep_ = 0; rep_ < ((MK_DUP == (k)) ? 2 : 1); ++rep_)
#define RUN(k) (lo <= (k) && (k) < hi)
#define SEAM(k) do { if (RUN(k) && RUN((k) + 1)) xcd_barrier(bar); } while (0)

#define h (a.out)
#define h16 ((bf16*)(opq(a.ws) + WS_H16))
#define hb ((bf16*)(opq(a.ws) + WS_HB))
#define aff ((float*)(opq(a.ws) + WS_AFF))
#define inv ((int*)(opq(a.ws) + WS_INV))
#define tok ((int*)(opq(a.ws) + WS_TOK))
#define gate ((float*)(opq(a.ws) + WS_GATE))
#define rcs ((float*)(opq(a.ws) + WS_ROPE))
#define rsn ((float*)(opq(a.ws) + WS_ROPE) + SEQ * 128)
#define wci ((bf16*)(opq(a.ws) + WS_WCI))
#define wco ((bf16*)(opq(a.ws) + WS_WCO))
#define wri ((bf16*)(opq(a.ws) + WS_WRI))
#define wrv ((bf16*)(opq(a.ws) + WS_WRI) + (size_t)4096 * (MK_RET_I8 ? D / 2 : D))
#define wro ((bf16*)(opq(a.ws) + WS_WRO))
#define wpg ((bf16*)(opq(a.ws) + WS_WPG))
#define wpp ((bf16*)(opq(a.ws) + WS_WPP))
#define we1 ((bf16*)(opq(a.ws) + WS_WE1))
#define we2 ((bf16*)(opq(a.ws) + WS_WE2))
#define scr (opq(a.ws) + WS_SCR)
#define tscr ((LAS float*)(F.lds + RING_OFF + F.wave * 16384))
#define ring (F.lds + RING_OFF)
    if (EN(0) && RUN(0)) {
        transpose_matrix<8>(F, a.conv_w_in, D, 3 * D, wci, tscr);
        transpose_matrix<0>(F, a.conv_w_out, D, D, wco, tscr);
        transpose_matrix<MK_RET_I8 ? 7 : 4>(F, a.ret_w_in, D, 6 * D, wri, tscr);
        transpose_matrix<5>(F, a.ret_w_out, RVW, D, wro, tscr);
        for (int l = 0; l < 2; ++l) {
            transpose_matrix<6>(F, a.ple_w_gate + (size_t)l * D * D, D, D, wpg + (size_t)l * D * (D / 2), tscr);
            transpose_matrix<0>(F, a.ple_w_proj + (size_t)l * PLE * D, PLE, D, wpp + (size_t)l * D * PLE, tscr);
        }
        convert_experts(F, a, 0, tscr);
        rope_table_phase(F, rcs, rsn);
        norm_rows_phase(F, a.x, nullptr, nullptr, a.norm_mix, hb, true);
    }
    SEAM(0);

    if (EN(1) && RUN(1)) {
        pg8::StaticOrder S; S.init(T, 3 * D, F.G, (int)blockIdx.x);
        pg8::SrcPlain X{hb, wci, D / 2};
        pg8::EpiConvIn E{(bf16*)(scr + SC_CB), (bf16*)(scr + SC_CU), 1.0f / (QA_HN * QW_1024)};
        pg8::gemm_phase<1>(ring, S, X, E);
    }
    SEAM(1);
    if (EN(2) && RUN(2)) REP(2) conv_phase(F, (const bf16*)(scr + SC_CB), (const bf16*)(scr + SC_CU), (bf16*)(scr + SC_CZ), a.conv_w, a.conv_b);
    SEAM(2);
    if (EN(3) && RUN(3)) {
        pg8::StaticOrder S; S.init(T, D, F.G, (int)blockIdx.x);
        pg8::SrcPlain X{(const bf16*)(scr + SC_CZ), wco, D};
        pg8::EpiBf16 E{(bf16*)(scr + SC_D0), D, 1.0f};
        pg8::gemm_phase<0>(ring, S, X, E);
    }
    SEAM(3);
#define MOE_BLOCK(l, pb) \
    if (EN(4) && RUN(pb + 0)) REP(pb + 0) router_phase(F, (l == 0) ? a.x : (const float*)nullptr, (const bf16*)(scr + ((l == 0) ? SC_D0 : SC_D7)), h16, a.norm_ffn + (size_t)l * D, a.router_w + (size_t)l * D * NE, hb, aff); \
    SEAM(pb + 0); \
    if (EN(5) && RUN(pb + 1)) REP(pb + 1) topk_phase(F, aff, tok, gate, inv); \
    SEAM(pb + 1); \
    if (EN(6) && RUN(pb + 2)) { \
        pg8::ExpertOrder S; S.init(16, F.G, (int)blockIdx.x); \
        LAS unsigned short* tl = (LAS unsigned short*)(F.lds + TOK_OFF); \
        for (int k = 0; k < 16; ++k) { const int i = 2 * k + (F.tid >> 8), rr = F.tid & 255; pg8::Unit u; if (S.next(i, u)) tl[i * 256 + rr] = (unsigned short)tok[u.pm * 256 + rr]; } \
        __syncthreads(); \
        pg8::SrcExpert1 X{hb, we1, D / 2, tl}; \
        pg8::EpiSwiglu E{(bf16*)(scr + SC_ACT)}; \
        pg8::gemm_phase<1>(ring, S, X, E); \
    } \
    SEAM(pb + 2); \
    if (EN(7) && RUN(pb + 3)) { \
        pg8::ExpertOrder S; S.init(4, F.G, (int)blockIdx.x); \
        pg8::SrcExpert2 X{(const bf16*)(scr + SC_ACT), we2, FF / 2}; \
        pg8::EpiDown E{(bf16*)(scr + SC_Y), gate}; \
        pg8::gemm_phase<1>(ring, S, X, E); \
    } \
    SEAM(pb + 3); \
    if (EN(8) && RUN(pb + 4)) { \
        combine_phase(F, h16, (const bf16*)(scr + SC_Y), inv, a.norm_ple + (size_t)l * D, hb); \
        convert_p_phase(F, a.p + (size_t)l * T * PLE, (bf16*)(scr + SC_PB)); \
        if (l == 0) convert_experts(F, a, 1, tscr); \
    } \
    SEAM(pb + 4); \
    if (EN(9) && RUN(pb + 5)) { \
        pg8::StaticOrder S; S.init(T, D, F.G, (int)blockIdx.x); \
        pg8::SrcPlain X{(const bf16*)(scr + SC_PB), wpp + (size_t)l * D * PLE, PLE}; \
        pg8::EpiI8 E{(unsigned char*)(scr + SC_PP), D, QA_PP}; \
        pg8::gemm_phase<0>(ring, S, X, E); \
    } \
    SEAM(pb + 5); \
    if (EN(10) && RUN(pb + 6)) { \
        pg8::StaticOrder S; S.init(T, D, F.G, (int)blockIdx.x); \
        pg8::SrcPlain X{hb, wpg + (size_t)l * D * (D / 2), D / 2}; \
        pg8::EpiPle E{(unsigned char*)(scr + SC_T), (const unsigned char*)(scr + SC_PP)}; \
        pg8::gemm_phase<1>(ring, S, X, E); \
    } \
    SEAM(pb + 6);
    MOE_BLOCK(0, 4)
    if (EN(11) && RUN(11)) REP(11) norm_rows_phase(F, nullptr, h16, (const bf16*)(scr + SC_T), a.norm_mix + D, hb, MK_RET_I8 != 0);
    SEAM(11);
    if (EN(12) && RUN(12)) {
        pg8::StaticOrder S; S.init(T, 4096, F.G, (int)blockIdx.x);
        pg8::SrcPlain X{hb, wri, MK_RET_I8 ? D / 2 : D};
        pg8::EpiRetIn E{(unsigned char*)(scr + SC_Q), (unsigned char*)(scr + SC_K), (bf16*)(scr + SC_G), rcs, rsn, MK_RET_I8 ? 1.0f / (QA_HN * QW_1024) : 1.0f};
        pg8::gemm_phase<MK_RET_I8 ? 1 : 0>(ring, S, X, E);
    }
    if (EN(13) && RUN(13)) {
        pg8::StaticOrder S; S.init(RVW, T, F.G, (int)blockIdx.x);
        pg8::SrcPlain X{wrv, hb, MK_RET_I8 ? D / 2 : D};
        pg8::EpiVT E{(bf16*)(scr + SC_VT), MK_RET_I8 ? 1.0f / (QA_HN * QW_1024) : 1.0f};
        pg8::gemm_phase<MK_RET_I8 ? 1 : 0>(ring, S, X, E);
    }
    SEAM(13);
    if (EN(14) && RUN(14)) REP(14) ret::retention_phase(F, (const unsigned char*)(scr + SC_Q), (const unsigned char*)(scr + SC_K), (const bf16*)(scr + SC_VT), (const bf16*)(scr + SC_G), (unsigned char*)hb, a.ret_log_decay, (MK_DUP != 14) || rep_ == 1 || a.ph_hi == 12345);
    SEAM(14);
    if (EN(15) && RUN(15)) {
        pg8::StaticOrder S; S.init(T, D, F.G, (int)blockIdx.x);
        pg8::SrcPlain X{hb, wro, RVW / 2};
        pg8::EpiBf16 E{(bf16*)(scr + SC_D7), D, 1.0f / (QA_OG * QW_2048)};
        pg8::gemm_phase<1>(ring, S, X, E);
    }
    SEAM(15);
    MOE_BLOCK(1, 16)
#undef MOE_BLOCK
    if (EN(23) && RUN(23)) REP(23) final_rows_phase(F, h, h16, (const bf16*)(scr + SC_T), a.final_norm);
#undef RUN
#undef SEAM
#undef h
#undef h16
#undef hb
#undef aff
#undef inv
#undef tok
#undef gate
#undef rcs
#undef rsn
#undef wci
#undef wco
#undef wri
#undef wrv
#undef wro
#undef wpg
#undef wpp
#undef we1
#undef we2
#undef scr
#undef tscr
#undef ring
}

extern "C" void kernel_launch(void* const* d_in, const int* in_sizes, int n_in, void* d_out, int out_size, void* d_ws, size_t ws_size, hipStream_t stream) {
    static int grid = 0;
    if (grid == 0) {
        if (n_in != 19 || in_sizes[0] != T * D || out_size != T * D || ws_size < WS_END) { fprintf(stderr, "kernel_launch: unexpected shapes/workspace (n_in %d, ws %zu); nothing launched\n", n_in, ws_size); grid = -1; return; }
        int dev = 0, cus = 0, per_cu = 0;
        if (hipGetDevice(&dev) != hipSuccess || hipDeviceGetAttribute(&cus, hipDeviceAttributeMultiprocessorCount, dev) != hipSuccess) { grid = -1; return; }
        if (hipFuncSetAttribute((const void*)enc_fwd, hipFuncAttributeMaxDynamicSharedMemorySize, LDS_BYTES) != hipSuccess) { fprintf(stderr, "kernel_launch: hipFuncSetAttribute failed\n"); grid = -1; return; }
        if (hipOccupancyMaxActiveBlocksPerMultiprocessor(&per_cu, (const void*)enc_fwd, NTHREADS, LDS_BYTES) != hipSuccess || per_cu < 1) { fprintf(stderr, "kernel_launch: occupancy query reports %d\n", per_cu); }
        (void)hipGetLastError();
        grid = cus;
    }
    if (grid < 0) return;
    if (hipMemsetAsync((char*)d_ws + WS_CTL, 0, CTL_ZERO_BYTES, stream) != hipSuccess) return;
    Args a{};
    a.x = (const float*)d_in[0]; a.p = (const float*)d_in[1]; a.norm_mix = (const float*)d_in[2]; a.norm_ffn = (const float*)d_in[3]; a.norm_ple = (const float*)d_in[4]; a.final_norm = (const float*)d_in[5];
    a.conv_w_in = (const float*)d_in[6]; a.conv_w = (const float*)d_in[7]; a.conv_b = (const float*)d_in[8]; a.conv_w_out = (const float*)d_in[9];
    a.ret_w_in = (const float*)d_in[10]; a.ret_log_decay = (const float*)d_in[11]; a.ret_w_out = (const float*)d_in[12]; a.router_w = (const float*)d_in[13];
    a.exp_w_gate = (const float*)d_in[14]; a.exp_w_up = (const float*)d_in[15]; a.exp_w_down = (const float*)d_in[16]; a.ple_w_proj = (const float*)d_in[17]; a.ple_w_gate = (const float*)d_in[18];
    a.out = (float*)d_out; a.ws = (unsigned char*)d_ws;
#if MK_PER_PHASE
    for (int ph = 0; ph < N_PHASES; ++ph) { a.ph_lo = ph; a.ph_hi = ph + 1; hipLaunchKernelGGL(enc_fwd, dim3(grid), dim3(NTHREADS), LDS_BYTES, stream, a); }
#else
    a.ph_lo = 0; a.ph_hi = N_PHASES;
    hipLaunchKernelGGL(enc_fwd, dim3(grid), dim3(NTHREADS), LDS_BYTES, stream, a);
#endif
    const hipError_t le = hipPeekAtLastError();
    if (le != hipSuccess) fprintf(stderr, "kernel_launch: launch failed: %s\n", hipGetErrorName(le));
}
```

```cpp
#include <hip/hip_runtime.h>
#include <cstdio>
#include <cstdint>

#ifndef MK_DUP
#define MK_DUP -1
#endif
#ifndef MK_RET_I8
#define MK_RET_I8 1
#endif
#define QA_HN 32.0f
#define QA_ACT 16.0f
#define QW_1024 1024.0f
#define QW_2048 1408.0f
#define QA_PP 32.0f
#define QA_T 40.0f
#define QA_QK 32.0f
#ifndef QA_OG
#define QA_OG 16.0f
#endif
#ifndef MK_PER_PHASE
#define MK_PER_PHASE 0
#endif

namespace pg8 {
#define PG8_LAS __attribute__((address_space(3)))
typedef unsigned short bf16_t;
typedef short bf16x8 __attribute__((ext_vector_type(8)));
typedef float f32x2 __attribute__((ext_vector_type(2)));
typedef float f32x4 __attribute__((ext_vector_type(4)));
typedef float f32x16 __attribute__((ext_vector_type(16)));
typedef unsigned u32x4 __attribute__((ext_vector_type(4)));
typedef unsigned u32x2 __attribute__((ext_vector_type(2)));
typedef int i32x4 __attribute__((ext_vector_type(4)));
typedef int i32x8 __attribute__((ext_vector_type(8)));
constexpr int BM = 256, BK = 64, HALF = 128, HTB = HALF * BK * 2, STAGE_BYTES = 8 * HTB, NXCD = 8, WGM = 8;

__host__ __device__ __forceinline__ int lds_byte(int r, int c) { const int st = (r >> 4) * 2 + (c >> 5), rr = r & 15, cc = c & 31, ob = rr * 64 + cc * 2; return st * 1024 + (ob ^ (((ob >> 9) & 1) << 5)); }
__host__ __device__ __forceinline__ void stage_rc(int b, int& R, int& C) { const int st = b / 1024, sb = b % 1024, swz = sb ^ (((sb >> 9) & 1) << 5); R = (st >> 1) * 16 + swz / 64; C = (st & 1) * 32 + (swz % 64) / 2; }
__host__ __device__ __forceinline__ int perm32(int rho) { const int n = rho >> 4, i = rho & 15; return 8 * (i >> 2) + 4 * n + (i & 3); }

struct Unit { int pm, pn; };

struct StaticOrder {
    int nM, nN, nwg, G, c;
    __device__ __forceinline__ void init(int M, int N, int G_, int c_) { nM = M / BM; nN = N / BM; nwg = nM * nN; G = G_; c = c_; }
    __device__ __forceinline__ bool next(int i, Unit& u) const {
        const long L = (long)i * G + c; if (L >= nwg) return false;
        int wgid = (int)L; { const int q = nwg / NXCD, r = nwg % NXCD, xcd = wgid % NXCD, off = wgid / NXCD; wgid = (xcd < r ? xcd * (q + 1) : r * (q + 1) + (xcd - r) * q) + off; }
        const int nig = WGM * nN, gid = wgid / nig, fm = gid * WGM, gsz = (nM - fm) < WGM ? (nM - fm) : WGM;
        u.pm = fm + ((wgid % nig) % gsz); u.pn = (wgid % nig) / gsz; return true;
    }
};
struct ExpertOrder {
    int nN, total, G, c;
    __device__ __forceinline__ void init(int nN_, int G_, int c_) { nN = nN_; total = 16 * 32 * nN_; G = G_; c = c_; }
    __device__ __forceinline__ bool next(int i, Unit& u) const {
        const long L = (long)i * G + c; if (L >= total) return false;
        const int l = (int)L, V = (l % NXCD) * (total / NXCD) + l / NXCD;
        const int per_e = 32 * nN, e = V / per_e, w = V % per_e, grp = 8 * nN, gq = w / grp, idx = w % grp;
        u.pm = e * 32 + gq * 8 + (idx & 7); u.pn = idx >> 3; return true;
    }
};

__device__ __forceinline__ unsigned cvt_pk_bf16(float lo, float hi) { unsigned r; asm volatile("v_cvt_pk_bf16_f32 %0, %1, %2" : "=v"(r) : "v"(lo), "v"(hi)); return r; }
__device__ __forceinline__ float bf_lo(unsigned w) { return __uint_as_float(w << 16); }
__device__ __forceinline__ float bf_hi(unsigned w) { return __uint_as_float(w & 0xffff0000u); }
__device__ __forceinline__ float clamp_f8(float x) { return fminf(fmaxf(x, -448.f), 448.f); }
__device__ __forceinline__ unsigned q8(float v, float sc) { float t = rintf(v * sc); t = fminf(fmaxf(t, -127.f), 127.f); return (unsigned)(int)t & 0xffu; }
__device__ __forceinline__ float fast_sigmoid(float x) { return __builtin_amdgcn_rcpf(1.0f + __builtin_amdgcn_exp2f(-1.44269504089f * x)); }
__device__ __forceinline__ float fast_silu(float x) { return x * fast_sigmoid(x); }
__device__ __forceinline__ f32x2 sigmoid_s2(const f32x2 a, const float s) {
    const f32x2 e = a * (f32x2){-1.44269504089f * s, -1.44269504089f * s};
    const f32x2 d = (f32x2){__builtin_amdgcn_exp2f(e[0]), __builtin_amdgcn_exp2f(e[1])} + (f32x2){1.0f, 1.0f};
    return (f32x2){__builtin_amdgcn_rcpf(d[0]), __builtin_amdgcn_rcpf(d[1])};
}
__device__ __forceinline__ unsigned pack4_i8(const f32x4 v) {
    const f32x4 w = v + (f32x4){12582912.0f, 12582912.0f, 12582912.0f, 12582912.0f};
    const unsigned b0 = __float_as_uint(__builtin_amdgcn_fmed3f(w[0], 12582912.0f - 127.0f, 12582912.0f + 127.0f)), b1 = __float_as_uint(__builtin_amdgcn_fmed3f(w[1], 12582912.0f - 127.0f, 12582912.0f + 127.0f));
    const unsigned b2 = __float_as_uint(__builtin_amdgcn_fmed3f(w[2], 12582912.0f - 127.0f, 12582912.0f + 127.0f)), b3 = __float_as_uint(__builtin_amdgcn_fmed3f(w[3], 12582912.0f - 127.0f, 12582912.0f + 127.0f));
    return __builtin_amdgcn_perm(b1, b0, 0x0c0c0400u) | __builtin_amdgcn_perm(b3, b2, 0x04000c0cu);
}

struct SrcPlain {
    static constexpr bool GATHER = false;
    const bf16_t* A; const bf16_t* Bt; int K;
    __device__ __forceinline__ const char* a_base(const Unit& u) const { return (const char*)(A + (size_t)u.pm * BM * K); }
    __device__ __forceinline__ const char* b_base(const Unit& u) const { return (const char*)(Bt + (size_t)u.pn * BM * K); }
};
struct SrcExpert2 {
    static constexpr bool GATHER = false;
    const bf16_t* A; const bf16_t* Bt; int K;
    __device__ __forceinline__ const char* a_base(const Unit& u) const { return (const char*)(A + (size_t)u.pm * BM * K); }
    __device__ __forceinline__ const char* b_base(const Unit& u) const { return (const char*)(Bt + ((size_t)(u.pm >> 5) * 1024 + (size_t)u.pn * BM) * K); }
};
struct SrcExpert1 {
    static constexpr bool GATHER = true;
    const bf16_t* A; const bf16_t* Bt; int K; const PG8_LAS unsigned short* tok;
    __device__ __forceinline__ const char* a_base(const Unit&) const { return (const char*)A; }
    __device__ __forceinline__ const char* b_base(const Unit& u) const { return (const char*)(Bt + ((size_t)(u.pm >> 5) * 4096 + (size_t)u.pn * BM) * K); }
    __device__ __forceinline__ unsigned a_off(const Unit& u, int round, int r, int C) const {
        const unsigned t = tok[round * 256 + r]; return (((unsigned)(u.pm & 31) * 2048u + t) * (unsigned)K + (unsigned)C) * 2u; }
};

template <int MODE  , class Epi, class Sched, class Src>
__device__ __forceinline__ void gemm_phase(PG8_LAS unsigned char* lds, const Sched& S, const Src& X, const Epi& E) {
    int tid_ = threadIdx.x; asm volatile("" : "+v"(tid_));
    const int tid = tid_, wid = __builtin_amdgcn_readfirstlane(tid >> 6), lane = tid & 63, wr = wid >> 2, wc = wid & 3, fr = lane & 15, fq = lane >> 4;
    const int K = X.K, nt = K / BK;
    unsigned voffA[2], voffB[2]; unsigned ocur[2][2], onxt[2][2]; int sR[2], sC[2];
    const size_t kstep = (size_t)(BK * 2);
    const size_t hstep = (size_t)HALF * K * 2;
#pragma unroll
    for (int i = 0; i < 2; ++i) { int R, C; stage_rc(tid * 16 + i * 8192, R, C); const int Rb = Epi::PERM ? ((R & ~31) + perm32(R & 31)) : R;
        sR[i] = R; sC[i] = C; voffB[i] = (unsigned)(Rb * K + C) * 2u; voffA[i] = (unsigned)(R * K + C) * 2u;
        ocur[0][i] = 0u; ocur[1][i] = 0u; onxt[0][i] = 0u; onxt[1][i] = 0u; }
    const unsigned ldsw = (unsigned)wid * 1024u;
    const int aoff = lds_byte(wr * 64 + fr, fq * 8), boff = lds_byte(wc * 32 + fr, fq * 8);
#define PG8_SA(b, h) (((b) * 2 + (h)) * HTB)
#define PG8_SB(b, h) ((4 + (b) * 2 + (h)) * HTB)
#define PG8_STAGE(bufoff, gbase, voff) do { _Pragma("unroll") for (int _i = 0; _i < 2; ++_i) \
        __builtin_amdgcn_global_load_lds((const unsigned*)((const char*)(gbase) + (voff)[_i]), (PG8_LAS unsigned*)(lds + (bufoff) + ldsw + _i * 8192), 16, 0, 0); } while (0)
#define PG8_STAGE_A(bufoff, ptr, h, OFF) do { if constexpr (Src::GATHER) { PG8_STAGE(bufoff, ptr, OFF[h]); } else { PG8_STAGE(bufoff, (ptr) + (h) * hstep, voffA); } } while (0)
#define PG8_LDA(dst, b, h) do { _Pragma("unroll") for (int m = 0; m < 4; ++m) { if constexpr (MODE == 2) { const i32x4 lo_ = *(const PG8_LAS i32x4*)(lds + PG8_SA(b, h) + aoff + m * 2048), hi_ = *(const PG8_LAS i32x4*)(lds + PG8_SA(b, h) + aoff + m * 2048 + 1024); dst##8[m] = __builtin_shufflevector(lo_, hi_, 0, 1, 2, 3, 4, 5, 6, 7); } \
        else { _Pragma("unroll") for (int k = 0; k < 2; ++k) dst[m][k] = *(const PG8_LAS bf16x8*)(lds + PG8_SA(b, h) + aoff + m * 2048 + k * 1024); } } } while (0)
#define PG8_LDB(dst, b, h) do { _Pragma("unroll") for (int n = 0; n < 2; ++n) { if constexpr (MODE == 2) { const i32x4 lo_ = *(const PG8_LAS i32x4*)(lds + PG8_SB(b, h) + boff + n * 2048), hi_ = *(const PG8_LAS i32x4*)(lds + PG8_SB(b, h) + boff + n * 2048 + 1024); dst##8[n] = __builtin_shufflevector(lo_, hi_, 0, 1, 2, 3, 4, 5, 6, 7); } \
        else { _Pragma("unroll") for (int k = 0; k < 2; ++k) dst[n][k] = *(const PG8_LAS bf16x8*)(lds + PG8_SB(b, h) + boff + n * 2048 + k * 1024); } } } while (0)
#define PG8_MMA(ai, bj, At, Bt) do { __builtin_amdgcn_s_setprio(1); _Pragma("unroll") for (int m = 0; m < 4; ++m) _Pragma("unroll") for (int n = 0; n < 2; ++n) _Pragma("unroll") for (int k = 0; k < 2; ++k) { \
        if constexpr (MODE == 0) acc[ai][bj][m][n] = __builtin_amdgcn_mfma_f32_16x16x32_bf16(Bt[n][k], At[m][k], acc[ai][bj][m][n], 0, 0, 0); \
        else if constexpr (MODE == 1) acc[ai][bj][m][n] = __builtin_bit_cast(f32x4, __builtin_amdgcn_mfma_i32_16x16x64_i8(__builtin_bit_cast(i32x4, Bt[n][k]), __builtin_bit_cast(i32x4, At[m][k]), __builtin_bit_cast(i32x4, acc[ai][bj][m][n]), 0, 0, 0)); \
        else if (k == 0) acc[ai][bj][m][n] = __builtin_amdgcn_mfma_scale_f32_16x16x128_f8f6f4(Bt##8[n], At##8[m], acc[ai][bj][m][n], 0, 0, 0, 0x7f7f7f7f, 0, 0x7f7f7f7f); } \
        __builtin_amdgcn_s_setprio(0); } while (0)
#define PG8_WAIT_V(n) asm volatile("s_waitcnt vmcnt(" #n ")" ::: "memory")
#define PG8_WAIT_L(n) asm volatile("s_waitcnt lgkmcnt(" #n ")" ::: "memory")
#define PG8_BAR __builtin_amdgcn_s_barrier()
#define PG8_SCHED __builtin_amdgcn_sched_barrier(0)
    Unit cur, nxt; int ui = 0;
    if (!S.next(0, cur)) return;
    f32x4 acc[2][2][4][2];
#pragma unroll
    for (int a = 0; a < 2; ++a)
#pragma unroll
        for (int b = 0; b < 2; ++b)
#pragma unroll
            for (int m = 0; m < 4; ++m)
#pragma unroll
                for (int n = 0; n < 2; ++n) acc[a][b][m][n] = (f32x4){0.f, 0.f, 0.f, 0.f};
    bf16x8 At[4][2], B0[2][2], B1[2][2]; i32x8 At8[4], B08[2], B18[2];
    const char* cA = X.a_base(cur); const char* cB = X.b_base(cur);
    if constexpr (Src::GATHER) {
#pragma unroll
        for (int h = 0; h < 2; ++h)
#pragma unroll
            for (int i = 0; i < 2; ++i) ocur[h][i] = X.a_off(cur, 0, h * HALF + sR[i], sC[i]);
        PG8_WAIT_L(0);
    }
    PG8_STAGE(PG8_SB(0, 0), cB, voffB); PG8_STAGE(PG8_SB(0, 1), cB + hstep, voffB); PG8_STAGE_A(PG8_SA(0, 0), cA, 0, ocur); PG8_STAGE_A(PG8_SA(0, 1), cA, 1, ocur);
    if (wr == 1) PG8_BAR;
    PG8_WAIT_V(2); PG8_BAR;
    PG8_STAGE(PG8_SB(1, 0), cB + kstep, voffB); PG8_STAGE_A(PG8_SA(1, 0), cA + kstep, 0, ocur); PG8_STAGE(PG8_SB(1, 1), cB + hstep + kstep, voffB);
    PG8_WAIT_V(6); PG8_BAR;
    for (;;) {
        const bool has_next = S.next(ui + 1, nxt);
        const char* nA = has_next ? X.a_base(nxt) : cA; const char* nB = has_next ? X.b_base(nxt) : cB;
        for (int t = 0; t < nt; t += 2) {
            const bool last = (t == nt - 2);
            const char* a1 = cA + (size_t)(t + 1) * kstep;
            const char* a2 = last ? nA : cA + (size_t)(t + 2) * kstep; const char* b2 = last ? nB : cB + (size_t)(t + 2) * kstep;
            const char* a3 = a2 + kstep; const char* b3 = b2 + kstep;
            unsigned o2[2][2];
            if constexpr (Src::GATHER) {
                if (last && has_next) {
#pragma unroll
                    for (int h = 0; h < 2; ++h)
#pragma unroll
                        for (int i = 0; i < 2; ++i) onxt[h][i] = X.a_off(nxt, ui + 1, h * HALF + sR[i], sC[i]);
                    PG8_WAIT_L(0);
                }
#pragma unroll
                for (int h = 0; h < 2; ++h)
#pragma unroll
                    for (int i = 0; i < 2; ++i) o2[h][i] = (last && has_next) ? onxt[h][i] : ocur[h][i];
            } else {
#pragma unroll
                for (int h = 0; h < 2; ++h)
#pragma unroll
                    for (int i = 0; i < 2; ++i) o2[h][i] = ocur[h][i];
            }
            PG8_LDB(B0, 0, 0); PG8_LDB(B1, 0, 1); PG8_SCHED; PG8_LDA(At, 0, 0); PG8_STAGE_A(PG8_SA(1, 1), a1, 1, ocur);
            PG8_WAIT_V(8); PG8_WAIT_L(0); PG8_BAR; PG8_MMA(0, 0, At, B0); PG8_MMA(0, 1, At, B1); PG8_BAR; PG8_SCHED;
            PG8_LDA(At, 0, 1); PG8_STAGE(PG8_SB(0, 0), b2, voffB); PG8_STAGE(PG8_SB(0, 1), b2 + hstep, voffB); PG8_STAGE_A(PG8_SA(0, 0), a2, 0, o2);
            PG8_WAIT_V(8); PG8_WAIT_L(0); PG8_BAR; PG8_MMA(1, 0, At, B0); PG8_MMA(1, 1, At, B1); PG8_BAR; PG8_SCHED;
            PG8_LDB(B0, 1, 0); PG8_LDB(B1, 1, 1); PG8_SCHED; PG8_LDA(At, 1, 0); PG8_STAGE_A(PG8_SA(0, 1), a2, 1, o2);
            PG8_WAIT_V(8); PG8_WAIT_L(0); PG8_BAR; PG8_MMA(0, 0, At, B0); PG8_MMA(0, 1, At, B1); PG8_BAR; PG8_SCHED;
            PG8_LDA(At, 1, 1); PG8_STAGE(PG8_SB(1, 0), b3, voffB); PG8_STAGE(PG8_SB(1, 1), b3 + hstep, voffB); PG8_STAGE_A(PG8_SA(1, 0), a3, 0, o2);
            PG8_WAIT_V(8); PG8_WAIT_L(0); PG8_BAR; PG8_MMA(1, 0, At, B0); PG8_MMA(1, 1, At, B1); PG8_BAR; PG8_SCHED;
        }
        if (wr == 0) PG8_BAR;
        if constexpr (MODE == 1 && !Epi::RAW_I32) {
#pragma unroll
            for (int a = 0; a < 2; ++a)
#pragma unroll
                for (int b = 0; b < 2; ++b)
#pragma unroll
                    for (int m = 0; m < 4; ++m)
#pragma unroll
                        for (int n = 0; n < 2; ++n) { const i32x4 iv = __builtin_bit_cast(i32x4, acc[a][b][m][n]); acc[a][b][m][n] = (f32x4){(float)iv[0], (float)iv[1], (float)iv[2], (float)iv[3]}; }
        }
        E(acc, cur, wr, wc, fr, fq);
        if (!has_next) break;
#pragma unroll
        for (int a = 0; a < 2; ++a)
#pragma unroll
            for (int b = 0; b < 2; ++b)
#pragma unroll
                for (int m = 0; m < 4; ++m)
#pragma unroll
                    for (int n = 0; n < 2; ++n) acc[a][b][m][n] = (f32x4){0.f, 0.f, 0.f, 0.f};
        cur = nxt; cA = nA; cB = nB; ++ui;
        if constexpr (Src::GATHER) {
#pragma unroll
            for (int h = 0; h < 2; ++h)
#pragma unroll
                for (int i = 0; i < 2; ++i) ocur[h][i] = onxt[h][i];
        }
        if (wr == 1) PG8_BAR;
    }
    PG8_WAIT_V(0);
    PG8_BAR;
#undef PG8_SA
#undef PG8_SB
#undef PG8_STAGE
#undef PG8_STAGE_A
#undef PG8_LDA
#undef PG8_LDB
#undef PG8_MMA
#undef PG8_WAIT_V
#undef PG8_WAIT_L
#undef PG8_BAR
#undef PG8_SCHED
}
}

constexpr int D = 1024, BATCH = 32, SEQ = 2048, T = BATCH * SEQ, NE = 16, CAP = 256, FF = 2048, PLE = 256;
constexpr int RH = 4, RQK = 256, RV = 512, RQW = 1024, RVW = 2048;
constexpr int NWAVES = 8, NTHREADS = 512;
constexpr float NORM_EPS = 1e-6f, GN_EPS = 1e-5f;

constexpr size_t MiB = 1u << 20;
constexpr size_t WS_CTL = 0, CTL_ZERO_BYTES = 1 * MiB;
constexpr size_t WS_AFF = 2 * MiB;
constexpr size_t WS_INV = 6 * MiB;
constexpr size_t WS_TOK = 10 * MiB;
constexpr size_t WS_GATE = 11 * MiB;
constexpr size_t WS_ROPE = 12 * MiB;
constexpr size_t WS_WCI = 16 * MiB;
constexpr size_t WS_WCO = 22 * MiB;
constexpr size_t WS_WRI = 24 * MiB;
constexpr size_t WS_WRO = 36 * MiB;
constexpr size_t WS_WPG = 40 * MiB;
constexpr size_t WS_WPP = 44 * MiB;
constexpr size_t WS_WE1 = 48 * MiB;
constexpr size_t WS_WE2 = 112 * MiB;
constexpr size_t WS_H16 = 144 * MiB;
constexpr size_t WS_HB = 272 * MiB;
constexpr size_t WS_SCR = 400 * MiB;
constexpr size_t WS_END = 1168 * MiB;
constexpr size_t SC_CB = 0, SC_CU = 128 * MiB, SC_CZ = 256 * MiB;
constexpr size_t SC_Q = 0, SC_K = 128 * MiB, SC_VT = 256 * MiB, SC_G = 512 * MiB;
constexpr size_t SC_ACT = 0, SC_Y = 512 * MiB;
constexpr size_t SC_PB = 0, SC_PP = 128 * MiB, SC_T = 256 * MiB;
constexpr size_t SC_D0 = 384 * MiB, SC_D7 = 0;
constexpr size_t SC_PB_UNUSED = 0;

constexpr int CW_BAR = 4096;

constexpr int RING_OFF = 0, RING_BYTES = 131072;
constexpr int TOK_OFF = RING_BYTES, TOK_BYTES = 32 * 256 * 2;
constexpr int MISC_OFF = TOK_OFF + TOK_BYTES;
constexpr int LDS_BYTES = MISC_OFF + 512;

#define GAS __attribute__((address_space(1)))
#define LAS __attribute__((address_space(3)))
typedef unsigned short bf16;
typedef unsigned v4u __attribute__((ext_vector_type(4)));
typedef unsigned v2u __attribute__((ext_vector_type(2)));
typedef float f32x4 __attribute__((ext_vector_type(4)));
typedef float f32x16 __attribute__((ext_vector_type(16)));
typedef short bf16x8 __attribute__((ext_vector_type(8)));
#define LDS_WAIT() asm volatile("s_waitcnt lgkmcnt(0)" ::: "memory")
#define VM_WAIT() asm volatile("s_waitcnt vmcnt(0)" ::: "memory")
__device__ __forceinline__ unsigned f2bf(float f) { unsigned u = __builtin_bit_cast(unsigned, f); return (u + 0x7fffu + ((u >> 16) & 1u)) >> 16; }
__device__ __forceinline__ unsigned pk2(float lo, float hi) { return f2bf(lo) | (f2bf(hi) << 16); }

#define XB_TMO      128
#define XB_XCNT(j)  (256  + 64 * (j))
#define XB_XSUB(j)  (1280 + 64 * (j))
#define XB_XGEN(j)  (2304 + 64 * (j))
#define XB_TOP      3328
#define XB_TOPGEN   3392
#define XCD_BAR_WORDS 3456
#define XB_SPIN_CAP (1u << 20)

__device__ __forceinline__ unsigned xb_ld(unsigned* p)              { return __hip_atomic_load(p, __ATOMIC_RELAXED, __HIP_MEMORY_SCOPE_AGENT); }
__device__ __forceinline__ unsigned xb_add(unsigned* p, unsigned v) { return __hip_atomic_fetch_add(p, v, __ATOMIC_RELAXED, __HIP_MEMORY_SCOPE_AGENT); }
__device__ __forceinline__ unsigned xb_xcc_id() { return (unsigned)__builtin_amdgcn_s_getreg((3 << 11) | 20) & 0xFu; }
#define XB_SPIN(cond, bar) do { unsigned _sp = 0; while (cond) { __builtin_amdgcn_s_sleep(1); \
    if ((++_sp & 255u) == 0u) { if (xb_ld(&(bar)[XB_TMO])) break; if (_sp > XB_SPIN_CAP) { atomicAdd(&(bar)[XB_TMO], 1u); break; } } } } while (0)

struct XcdBarrier { unsigned* bar; unsigned x; volatile LAS unsigned* st; };

__device__ __forceinline__ XcdBarrier xcd_barrier_post(unsigned* bar, volatile LAS unsigned* st) {
    XcdBarrier b; b.bar = bar; b.x = xb_xcc_id(); b.st = st;
    if (threadIdx.x == 0) (void)xb_add(&bar[XB_XCNT(b.x)], 1u);
    return b;
}
__device__ __forceinline__ void xcd_barrier_complete(unsigned* bar, unsigned x, unsigned& nloc, unsigned& nx) {
    const unsigned G = gridDim.x * gridDim.y * gridDim.z;
    unsigned sum, cnt, mine, sp = 0u;
    for (;;) {
        sum = 0u; cnt = 0u; mine = 0u;
#pragma unroll
        for (unsigned j = 0; j < 16; ++j) { const unsigned c = xb_ld(&bar[XB_XCNT(j)]); sum += c; cnt += (c > 0u) ? 1u : 0u; mine = (j == x) ? c : mine; }
        if (sum == G) break;
        __builtin_amdgcn_s_sleep(1);
        if ((++sp & 255u) == 0u) { if (xb_ld(&bar[XB_TMO])) break; if (sp > XB_SPIN_CAP) { atomicAdd(&bar[XB_TMO], 1u); break; } }
    }
    nloc = mine > 0u ? mine : 1u; nx = cnt > 0u ? cnt : 1u;
}
__device__ __forceinline__ void xcd_barrier(const XcdBarrier& b) {
    asm volatile("s_waitcnt vmcnt(0)" ::: "memory");
    __syncthreads();
    if (threadIdx.x == 0) {
        unsigned* bar = b.bar;
        __builtin_amdgcn_s_waitcnt(0);
        unsigned nloc = b.st[0], nx = b.st[1];
        if (nloc == 0u) { xcd_barrier_complete(bar, b.x, nloc, nx); b.st[0] = nloc; b.st[1] = nx; }
        const unsigned old = xb_add(&bar[XB_XSUB(b.x)], 1u);
        const unsigned gen = old / nloc;
        if (old + 1u == (gen + 1u) * nloc) {
            __builtin_amdgcn_fence(__ATOMIC_RELEASE, "agent");
            asm volatile("s_waitcnt vmcnt(0)" ::: "memory");
            const unsigned og = xb_add(&bar[XB_TOP], 1u);
            const unsigned tg = og / nx;
            if (og + 1u == (tg + 1u) * nx) xb_add(&bar[XB_TOPGEN], 1u);
            else XB_SPIN(xb_ld(&bar[XB_TOPGEN]) == tg, bar);
            __builtin_amdgcn_fence(__ATOMIC_ACQUIRE, "agent");
            xb_add(&bar[XB_XGEN(b.x)], 1u);
            asm volatile("s_waitcnt vmcnt(0)" ::: "memory");
        } else {
            XB_SPIN(xb_ld(&bar[XB_XGEN(b.x)]) == gen, bar);
            __builtin_amdgcn_fence(__ATOMIC_ACQUIRE, "agent");
            asm volatile("s_waitcnt vmcnt(0)" ::: "memory");
        }
    }
    __syncthreads();
}

__device__ __forceinline__ float wave_sum(float v) {
#pragma unroll
    for (int o = 1; o < 64; o <<= 1) v += __shfl_xor(v, o);
    return v;
}

namespace pg8 {
#define EPI_ROWLOOP _Pragma("unroll") for (int ai = 0; ai < 2; ++ai) _Pragma("unroll") for (int m = 0; m < 4; ++m)
__device__ __forceinline__ u32x4 pack8(const f32x4 a, const f32x4 b) { u32x4 w; w.x = cvt_pk_bf16(a[0], a[1]); w.y = cvt_pk_bf16(a[2], a[3]); w.z = cvt_pk_bf16(b[0], b[1]); w.w = cvt_pk_bf16(b[2], b[3]); return w; }

struct EpiBf16 {
    static constexpr bool PERM = true, RAW_I32 = false;
    bf16_t* O; int ldc; float qs;
    __device__ __forceinline__ void operator()(const f32x4 (&acc)[2][2][4][2], const Unit& u, int wr, int wc, int fr, int fq) const {
        const int row0 = u.pm * BM + wr * 64 + fr, col0 = u.pn * BM + wc * 32 + 8 * fq;
        EPI_ROWLOOP { bf16_t* rowp = O + (size_t)(row0 + ai * HALF + m * 16) * ldc + col0;
#pragma unroll
            for (int bj = 0; bj < 2; ++bj) *(u32x4*)(rowp + bj * HALF) = pack8(acc[ai][bj][m][0] * qs, acc[ai][bj][m][1] * qs); }
    }
};
struct EpiI8 {
    static constexpr bool PERM = true, RAW_I32 = false;
    unsigned char* O; int ldc; float qs;
    __device__ __forceinline__ void operator()(const f32x4 (&acc)[2][2][4][2], const Unit& u, int wr, int wc, int fr, int fq) const {
        const int row0 = u.pm * BM + wr * 64 + fr, col0 = u.pn * BM + wc * 32 + 8 * fq;
        EPI_ROWLOOP { unsigned char* rowp = O + (size_t)(row0 + ai * HALF + m * 16) * ldc + col0;
#pragma unroll
            for (int bj = 0; bj < 2; ++bj) { u32x2 w8; w8.x = pack4_i8(acc[ai][bj][m][0] * qs); w8.y = pack4_i8(acc[ai][bj][m][1] * qs); *(u32x2*)(rowp + bj * HALF) = w8; } }
    }
};
struct EpiConvIn {
    static constexpr bool PERM = true, RAW_I32 = false;
    bf16_t* Bb; bf16_t* Ub; float qs;
    __device__ __forceinline__ void operator()(const f32x4 (&acc)[2][2][4][2], const Unit& u, int wr, int wc, int fr, int fq) const {
        const int row0 = u.pm * BM + wr * 64 + fr;
        if (u.pn < 4) {
            const int col0 = u.pn * BM + wc * 32 + 8 * fq;
            EPI_ROWLOOP { bf16_t* rowp = Bb + (size_t)(row0 + ai * HALF + m * 16) * D_ + col0;
#pragma unroll
                for (int bj = 0; bj < 2; ++bj) *(u32x4*)(rowp + bj * HALF) = pack8(acc[ai][bj][m][0] * qs, acc[ai][bj][m][1] * qs); }
        } else {
            const int ch0 = (u.pn - 4) * HALF + wc * 32 + 8 * fq;
            EPI_ROWLOOP { bf16_t* rowp = Ub + (size_t)(row0 + ai * HALF + m * 16) * D_ + ch0;
                const float q2 = qs * qs;
                *(u32x4*)rowp = pack8(acc[ai][0][m][0] * acc[ai][1][m][0] * q2, acc[ai][0][m][1] * acc[ai][1][m][1] * q2); }
        }
    }
    static constexpr int D_ = 1024;
};
struct EpiSwiglu {
    static constexpr bool PERM = true, RAW_I32 = true; static constexpr float QS = 1.0f / (QA_HN * QW_1024);
    bf16_t* O;
    __device__ __forceinline__ f32x2 q2(float g0, float g1, float u0, float u1) const {
        const f32x2 ga = {(float)__float_as_int(g0), (float)__float_as_int(g1)}, ua = {(float)__float_as_int(u0), (float)__float_as_int(u1)};
        const f32x2 x = ga * (f32x2){-1.44269504089f * QS, -1.44269504089f * QS};
        const f32x2 d = (f32x2){__builtin_amdgcn_exp2f(x[0]), __builtin_amdgcn_exp2f(x[1])} + (f32x2){1.0f, 1.0f};
        const f32x2 sg = {__builtin_amdgcn_rcpf(d[0]), __builtin_amdgcn_rcpf(d[1])};
        f32x2 v = (ga * ua) * sg;
        v = v * (f32x2){QS * QS * QA_ACT, QS * QS * QA_ACT} + (f32x2){12582912.0f, 12582912.0f};
        v[0] = __builtin_amdgcn_fmed3f(v[0], 12582912.0f - 127.0f, 12582912.0f + 127.0f); v[1] = __builtin_amdgcn_fmed3f(v[1], 12582912.0f - 127.0f, 12582912.0f + 127.0f);
        return v;
    }
    __device__ __forceinline__ void operator()(const f32x4 (&acc)[2][2][4][2], const Unit& u, int wr, int wc, int fr, int fq) const {
        const int row0 = u.pm * BM + wr * 64 + fr, ch0 = u.pn * HALF + wc * 32 + 8 * fq;
        EPI_ROWLOOP { unsigned char* rowp = (unsigned char*)O + (size_t)(row0 + ai * HALF + m * 16) * 2048 + ch0;
            u32x2 w8;
#pragma unroll
            for (int n = 0; n < 2; ++n) { const f32x4 g = acc[ai][0][m][n], up = acc[ai][1][m][n];
                const f32x2 w01 = q2(g[0], g[1], up[0], up[1]), w23 = q2(g[2], g[3], up[2], up[3]);
                const unsigned b0 = __float_as_uint(w01[0]), b1 = __float_as_uint(w01[1]), b2 = __float_as_uint(w23[0]), b3 = __float_as_uint(w23[1]);
                const unsigned lo = __builtin_amdgcn_perm(b1, b0, 0x0c0c0400u), hi = __builtin_amdgcn_perm(b3, b2, 0x04000c0cu);
                const unsigned wv = lo | hi;
                if (n == 0) w8.x = wv; else w8.y = wv; }
            *(u32x2*)rowp = w8; }
    }
};
struct EpiDown {
    static constexpr bool PERM = true, RAW_I32 = false;
    bf16_t* O; const float* gate;
    __device__ __forceinline__ void operator()(const f32x4 (&acc)[2][2][4][2], const Unit& u, int wr, int wc, int fr, int fq) const {
        const int row0 = u.pm * BM + wr * 64 + fr, col0 = u.pn * BM + wc * 32 + 8 * fq;
        float gtv[2][4];
#pragma unroll
        for (int ai = 0; ai < 2; ++ai)
#pragma unroll
            for (int m = 0; m < 4; ++m) gtv[ai][m] = gate[row0 + ai * HALF + m * 16];
        EPI_ROWLOOP { const int row = row0 + ai * HALF + m * 16; const float gt = gtv[ai][m] * (1.0f / (QA_ACT * QW_2048))  ; bf16_t* rowp = O + (size_t)row * 1024 + col0;
#pragma unroll
            for (int bj = 0; bj < 2; ++bj) *(u32x4*)(rowp + bj * HALF) = pack8(acc[ai][bj][m][0] * gt, acc[ai][bj][m][1] * gt); }
    }
};
struct EpiResid {
    static constexpr bool PERM = false, RAW_I32 = false;
    const float* base; float* out;
    __device__ __forceinline__ void operator()(const f32x4 (&acc)[2][2][4][2], const Unit& u, int wr, int wc, int fr, int fq) const {
        const int row0 = u.pm * BM + wr * 64 + fr, col0 = u.pn * BM + wc * 32 + 4 * fq;
        EPI_ROWLOOP { const size_t off = (size_t)(row0 + ai * HALF + m * 16) * 1024 + col0;
#pragma unroll
            for (int bj = 0; bj < 2; ++bj)
#pragma unroll
                for (int n = 0; n < 2; ++n) { const f32x4 bs = *(const f32x4*)(base + off + bj * HALF + n * 16); *(f32x4*)(out + off + bj * HALF + n * 16) = bs + acc[ai][bj][m][n]; } }
    }
};
struct EpiPle {
    static constexpr bool PERM = true, RAW_I32 = false; static constexpr float QS = 1.0f / (QA_HN * QW_1024);
    unsigned char* out; const unsigned char* pp;
    __device__ __forceinline__ void operator()(const f32x4 (&acc)[2][2][4][2], const Unit& u, int wr, int wc, int fr, int fq) const {
        const int row0 = u.pm * BM + wr * 64 + fr, col0 = u.pn * BM + wc * 32 + 8 * fq;
        u32x2 ppv[2][4][2];
#pragma unroll
        for (int ai = 0; ai < 2; ++ai)
#pragma unroll
            for (int m = 0; m < 4; ++m)
#pragma unroll
                for (int bj = 0; bj < 2; ++bj) ppv[ai][m][bj] = *(const u32x2*)(pp + (size_t)(row0 + ai * HALF + m * 16) * 1024 + col0 + bj * HALF);
        EPI_ROWLOOP { const size_t off = (size_t)(row0 + ai * HALF + m * 16) * 1024 + col0;
#pragma unroll
            for (int bj = 0; bj < 2; ++bj) { const size_t o = off + bj * HALF; const u32x2 pw = ppv[ai][m][bj];
#define PP_B(w, k) ((float)(int)(signed char)((w) >> (8 * (k))))
                const f32x4 a0 = acc[ai][bj][m][0], a1 = acc[ai][bj][m][1];
                const f32x2 ip = {QA_T / QA_PP, QA_T / QA_PP};
                const f32x2 t0 = (sigmoid_s2((f32x2){a0[0], a0[1]}, QS) * ip) * (f32x2){PP_B(pw.x, 0), PP_B(pw.x, 1)}, t1 = (sigmoid_s2((f32x2){a0[2], a0[3]}, QS) * ip) * (f32x2){PP_B(pw.x, 2), PP_B(pw.x, 3)};
                const f32x2 t2 = (sigmoid_s2((f32x2){a1[0], a1[1]}, QS) * ip) * (f32x2){PP_B(pw.y, 0), PP_B(pw.y, 1)}, t3 = (sigmoid_s2((f32x2){a1[2], a1[3]}, QS) * ip) * (f32x2){PP_B(pw.y, 2), PP_B(pw.y, 3)};
#undef PP_B
                u32x2 ow; ow.x = pack4_i8((f32x4){t0[0], t0[1], t1[0], t1[1]}); ow.y = pack4_i8((f32x4){t2[0], t2[1], t3[0], t3[1]});
                *(u32x2*)(out + o) = ow; } }
    }
};
struct EpiRetIn {
    static constexpr bool PERM = true, RAW_I32 = false;
    unsigned char* Q; unsigned char* Kk; bf16_t* G; const float* cs; const float* sn; float qs;
    __device__ __forceinline__ void operator()(const f32x4 (&acc)[2][2][4][2], const Unit& u, int wr, int wc, int fr, int fq) const {
        const int row0 = u.pm * BM + wr * 64 + fr;
        if (u.pn < 8) {
            const int hd = u.pn & 3; unsigned char* dst = (u.pn < 4) ? Q : Kk; const float sc = QA_QK * qs;
            const int j0 = wc * 32 + 8 * fq;
#pragma unroll
            for (int ai = 0; ai < 2; ++ai) { f32x4 tc[4][2], ts[4][2];
#pragma unroll
              for (int m = 0; m < 4; ++m) { const int s = (row0 + ai * HALF + m * 16) & 2047;
                  tc[m][0] = *(const f32x4*)(cs + s * 128 + j0); tc[m][1] = *(const f32x4*)(cs + s * 128 + j0 + 4); ts[m][0] = *(const f32x4*)(sn + s * 128 + j0); ts[m][1] = *(const f32x4*)(sn + s * 128 + j0 + 4); }
#pragma unroll
              for (int m = 0; m < 4; ++m) { const int row = row0 + ai * HALF + m * 16, b = row >> 11, s = row & 2047;
                const f32x4 c0 = tc[m][0], c1 = tc[m][1], s0 = ts[m][0], s1 = ts[m][1];
                const f32x4 x10 = acc[ai][0][m][0], x11 = acc[ai][0][m][1], x20 = acc[ai][1][m][0], x21 = acc[ai][1][m][1];
                const f32x4 o10 = (x10 * c0 - x20 * s0) * sc, o11 = (x11 * c1 - x21 * s1) * sc, o20 = (x10 * s0 + x20 * c0) * sc, o21 = (x11 * s1 + x21 * c1) * sc;
                unsigned char* rowp = dst + ((size_t)(b * 4 + hd) * 2048 + s) * 256 + j0;
                u32x2 w1, w2;
                w1.x = pack4_i8(o10); w1.y = pack4_i8(o11); w2.x = pack4_i8(o20); w2.y = pack4_i8(o21);
                *(u32x2*)rowp = w1; *(u32x2*)(rowp + 128) = w2; } }
        } else {
            const int col0 = (u.pn - 8) * BM + wc * 32 + 8 * fq;
            EPI_ROWLOOP { bf16_t* rowp = G + (size_t)(row0 + ai * HALF + m * 16) * 2048 + col0;
#pragma unroll
                for (int bj = 0; bj < 2; ++bj) { u32x4 ow;
#pragma unroll
                    for (int n = 0; n < 2; ++n) { const f32x4 a = acc[ai][bj][m][n];
                        const f32x2 x0 = {a[0], a[1]}, x1 = {a[2], a[3]};
                        const f32x2 r0 = (x0 * (f32x2){qs, qs}) * sigmoid_s2(x0, qs), r1 = (x1 * (f32x2){qs, qs}) * sigmoid_s2(x1, qs);
                        const unsigned w0 = cvt_pk_bf16(r0[0], r0[1]), w1 = cvt_pk_bf16(r1[0], r1[1]);
                        if (n == 0) { ow.x = w0; ow.y = w1; } else { ow.z = w0; ow.w = w1; } }
                    *(u32x4*)(rowp + bj * HALF) = ow; } }
        }
    }
};
struct EpiVT {
    static constexpr bool PERM = true, RAW_I32 = false;
    bf16_t* VT; float qs;
    __device__ __forceinline__ void operator()(const f32x4 (&acc)[2][2][4][2], const Unit& u, int wr, int wc, int fr, int fq) const {
        const int row0 = u.pm * BM + wr * 64 + fr, col0 = u.pn * BM + wc * 32 + 8 * fq;
        const int b = col0 >> 11, s0 = col0 & 2047;
        EPI_ROWLOOP { const int R = row0 + ai * HALF + m * 16, hd = R >> 9, dv = R & 511;
#pragma unroll
            for (int bj = 0; bj < 2; ++bj) { const int s = s0 + bj * HALF;
                *(u32x4*)(VT + (((size_t)(b * 4 + hd) * 64 + (s >> 5)) * 512 + dv) * 32 + (s & 31)) = pack8(acc[ai][bj][m][0] * qs, acc[ai][bj][m][1] * qs); } }
    }
};
#undef EPI_ROWLOOP
}

struct Args {
    const float* x; const float* p; const float* norm_mix; const float* norm_ffn; const float* norm_ple; const float* final_norm;
    const float* conv_w_in; const float* conv_w; const float* conv_b; const float* conv_w_out;
    const float* ret_w_in; const float* ret_log_decay; const float* ret_w_out; const float* router_w;
    const float* exp_w_gate; const float* exp_w_up; const float* exp_w_down; const float* ple_w_proj; const float* ple_w_gate;
    float* out; unsigned char* ws; int ph_lo, ph_hi;
};
struct Frame {
    LAS unsigned char* lds; int tid, lane, wave, G, vcu, gw, NGW;
};

__device__ __forceinline__ void transpose_item(const float* W, int K, int N, bf16* WT, int k0, int n0, int drow0, LAS float* scr, int lane) {
#pragma unroll 8
    for (int i = 0; i < 32; ++i) { const int kk = 2 * i + (lane >> 5); scr[kk * 33 + (lane & 31)] = W[(size_t)(k0 + kk) * N + n0 + (lane & 31)]; }
    LDS_WAIT(); asm volatile("" ::: "memory");
    const int c = lane & 7;
#pragma unroll
    for (int j = 0; j < 4; ++j) { const int n = (lane >> 3) + 8 * j; const LAS float* s = scr + (8 * c) * 33 + n;
        v4u o; o.x = pk2(s[0 * 33], s[1 * 33]); o.y = pk2(s[2 * 33], s[3 * 33]); o.z = pk2(s[4 * 33], s[5 * 33]); o.w = pk2(s[6 * 33], s[7 * 33]);
        *(GAS v4u*)(WT + (size_t)(drow0 + n) * K + k0 + 8 * c) = o; }
    LDS_WAIT(); asm volatile("" ::: "memory");
}
using pg8::q8;
__device__ __forceinline__ void transpose_item_i8(const float* W, int K, int N, unsigned char* WT, int k0, int n0, int drow0, float qscale, LAS float* scr, int lane) {
#pragma unroll 8
    for (int i = 0; i < 32; ++i) { const int kk = 2 * i + (lane >> 5); scr[kk * 33 + (lane & 31)] = W[(size_t)(k0 + kk) * N + n0 + (lane & 31)]; }
    LDS_WAIT(); asm volatile("" ::: "memory");
    const int c = lane & 7;
#pragma unroll
    for (int j = 0; j < 4; ++j) { const int n = (lane >> 3) + 8 * j; const LAS float* s = scr + (8 * c) * 33 + n;
        v2u o; o.x = pg8::pack4_i8((f32x4){s[0 * 33], s[1 * 33], s[2 * 33], s[3 * 33]} * qscale);
        o.y = pg8::pack4_i8((f32x4){s[4 * 33], s[5 * 33], s[6 * 33], s[7 * 33]} * qscale);
        *(GAS v2u*)(WT + (size_t)(drow0 + n) * K + k0 + 8 * c) = o; }
    LDS_WAIT(); asm volatile("" ::: "memory");
}
__device__ __forceinline__ void transpose_item_f8(const float* W, int K, int N, unsigned char* WT, int k0, int n0, int drow0, float qscale, LAS float* scr, int lane) {
#pragma unroll 8
    for (int i = 0; i < 32; ++i) { const int kk = 2 * i + (lane >> 5); scr[kk * 33 + (lane & 31)] = W[(size_t)(k0 + kk) * N + n0 + (lane & 31)]; }
    LDS_WAIT(); asm volatile("" ::: "memory");
    const int c = lane & 7;
#pragma unroll
    for (int j = 0; j < 4; ++j) { const int n = (lane >> 3) + 8 * j; const LAS float* s = scr + (8 * c) * 33 + n;
        v2u o; int t_ = 0;
        t_ = __builtin_amdgcn_cvt_pk_fp8_f32(pg8::clamp_f8(s[0 * 33] * qscale), pg8::clamp_f8(s[1 * 33] * qscale), t_, false); t_ = __builtin_amdgcn_cvt_pk_fp8_f32(pg8::clamp_f8(s[2 * 33] * qscale), pg8::clamp_f8(s[3 * 33] * qscale), t_, true); o.x = (unsigned)t_;
        t_ = __builtin_amdgcn_cvt_pk_fp8_f32(pg8::clamp_f8(s[4 * 33] * qscale), pg8::clamp_f8(s[5 * 33] * qscale), t_, false); t_ = __builtin_amdgcn_cvt_pk_fp8_f32(pg8::clamp_f8(s[6 * 33] * qscale), pg8::clamp_f8(s[7 * 33] * qscale), t_, true); o.y = (unsigned)t_;
        *(GAS v2u*)(WT + (size_t)(drow0 + n) * K + k0 + 8 * c) = o; }
    LDS_WAIT(); asm volatile("" ::: "memory");
}
template <int MAP  >
__device__ __forceinline__ void transpose_matrix(const Frame& F, const float* W, int K, int N, bf16* WT, LAS float* scr) {
    const int nblk = N / 32, nitems = (K / 64) * nblk;
    for (int it = F.gw; it < nitems; it += F.NGW) {
        const int kb = it / nblk, nb = it % nblk, n0 = 32 * nb; int drow0 = n0;
        if (MAP == 1 || MAP == 8) { if (n0 >= 1024) { const int v = (n0 >= 2048) ? 1 : 0, d = n0 - 1024 - 1024 * v; drow0 = 1024 + 256 * (d >> 7) + 128 * v + (d & 127); } }
        if (MAP == 2) drow0 = 256 * (n0 >> 7) + (n0 & 127);
        if (MAP == 3) drow0 = 256 * (n0 >> 7) + 128 + (n0 & 127);
        if (MAP == 4 || MAP == 7) { if (n0 >= 4096) drow0 = n0 - 2048; else if (n0 >= 2048) drow0 = n0 + 2048; }
        if (MAP == 5) transpose_item_i8(W, K, N, (unsigned char*)WT, 64 * kb, n0, drow0, QW_2048, scr, F.lane);
        else if (MAP == 6 || MAP == 7 || MAP == 8) transpose_item_i8(W, K, N, (unsigned char*)WT, 64 * kb, n0, drow0, QW_1024, scr, F.lane);
        else if (MAP == 2 || MAP == 3) transpose_item_i8(W, K, N, (unsigned char*)WT, 64 * kb, n0, drow0, QW_1024, scr, F.lane);
        else transpose_item(W, K, N, WT, 64 * kb, n0, drow0, scr, F.lane);
    }
}
__device__ __forceinline__ void convert_experts(const Frame& F, const Args& a, int layer, LAS float* scr) {
    bf16* we1 = (bf16*)(a.ws + WS_WE1); bf16* we2 = (bf16*)(a.ws + WS_WE2);
    for (int e = 0; e < NE; ++e) {
        const size_t wofs = ((size_t)layer * NE + e) * (size_t)D * FF;
        transpose_matrix<2>(F, a.exp_w_gate + wofs, D, FF, we1 + (size_t)e * 4096 * (D / 2), scr);
        transpose_matrix<3>(F, a.exp_w_up + wofs, D, FF, we1 + (size_t)e * 4096 * (D / 2), scr);
        transpose_matrix<5>(F, a.exp_w_down + wofs, FF, D, we2 + (size_t)e * D * (FF / 2), scr);
    }
}

using pg8::q8;
__device__ __forceinline__ void load_row(const float* xrow, int lane, f32x4 (&v)[4]) {
    const GAS f32x4* xr = (const GAS f32x4*)xrow + lane;
#pragma unroll
    for (int j = 0; j < 4; ++j) v[j] = xr[64 * j];
}
__device__ __forceinline__ float row_rs(const f32x4 (&v)[4]) {
    float s = 0.f;
#pragma unroll
    for (int j = 0; j < 4; ++j) s += (v[j].x * v[j].x + v[j].y * v[j].y) + (v[j].z * v[j].z + v[j].w * v[j].w);
    return 1.0f / sqrtf(wave_sum(s) * (1.f / D) + NORM_EPS);
}
__device__ __forceinline__ void store_row_bf16(bf16* orow, int lane, const f32x4 (&v)[4]) {
    GAS unsigned long long* o8 = (GAS unsigned long long*)orow + lane;
#pragma unroll
    for (int j = 0; j < 4; ++j) o8[64 * j] = (unsigned long long)pk2(v[j].x, v[j].y) | ((unsigned long long)pk2(v[j].z, v[j].w) << 32);
}
__device__ __forceinline__ void load_row_bf16(const bf16* hrow, int lane, f32x4 (&v)[4]) {
    const GAS unsigned long long* hr = (const GAS unsigned long long*)hrow + lane;
#pragma unroll
    for (int j = 0; j < 4; ++j) { const unsigned long long w = hr[64 * j]; const unsigned lo = (unsigned)w, hi = (unsigned)(w >> 32);
        v[j].x = pg8::bf_lo(lo); v[j].y = pg8::bf_hi(lo); v[j].z = pg8::bf_lo(hi); v[j].w = pg8::bf_hi(hi); }
}
__device__ __forceinline__ void add_delta_row(const bf16* drow, int lane, f32x4 (&v)[4]) {
    const GAS unsigned long long* dr = (const GAS unsigned long long*)drow + lane;
#pragma unroll
    for (int j = 0; j < 4; ++j) { const unsigned long long w = dr[64 * j]; const unsigned lo = (unsigned)w, hi = (unsigned)(w >> 32);
        v[j].x += pg8::bf_lo(lo); v[j].y += pg8::bf_hi(lo); v[j].z += pg8::bf_lo(hi); v[j].w += pg8::bf_hi(hi); }
}
__device__ __forceinline__ void add_delta_row_i8(const unsigned char* drow, int lane, f32x4 (&v)[4], float inv) {
    const GAS unsigned* dr = (const GAS unsigned*)drow + lane;
#pragma unroll
    for (int j = 0; j < 4; ++j) { const unsigned w = dr[64 * j];
        v[j] = (f32x4){(float)(int)(signed char)w, (float)(int)(signed char)(w >> 8), (float)(int)(signed char)(w >> 16), (float)((int)w >> 24)} * inv + v[j]; }
}
__device__ __forceinline__ void store_row_f32(float* orow, int lane, const f32x4 (&v)[4]) {
    GAS f32x4* o = (GAS f32x4*)orow + lane;
#pragma unroll
    for (int j = 0; j < 4; ++j) o[64 * j] = v[j];
}
__device__ __forceinline__ void norm_rows_phase(const Frame& F, const float* src, bf16* h16, const bf16* delta, const float* gain, bf16* dst, bool i8out = false) {
    f32x4 g[4]; load_row(gain, F.lane, g);
    for (int m = F.gw; m < T; m += F.NGW) {
        f32x4 v[4];
        if (src) load_row(src + (size_t)m * D, F.lane, v);
        else { load_row_bf16(h16 + (size_t)m * D, F.lane, v); add_delta_row_i8((const unsigned char*)delta + (size_t)m * D, F.lane, v, 1.0f / QA_T); store_row_bf16(h16 + (size_t)m * D, F.lane, v); }
        const float rs = row_rs(v);
#pragma unroll
        for (int j = 0; j < 4; ++j) v[j] = v[j] * rs * g[j];
        if (i8out) { GAS unsigned* o4 = (GAS unsigned*)((unsigned char*)dst + (size_t)m * D) + F.lane;
#pragma unroll
            for (int jj = 0; jj < 4; ++jj) o4[64 * jj] = pg8::pack4_i8(v[jj] * QA_HN); }
        else store_row_bf16(dst + (size_t)m * D, F.lane, v);
    }
}
__device__ __forceinline__ void final_rows_phase(const Frame& F, float* h, const bf16* h16, const bf16* delta, const float* gain) {
    f32x4 g[4]; load_row(gain, F.lane, g);
    for (int m = F.gw; m < T; m += F.NGW) {
        f32x4 v[4]; load_row_bf16(h16 + (size_t)m * D, F.lane, v); add_delta_row_i8((const unsigned char*)delta + (size_t)m * D, F.lane, v, 1.0f / QA_T); const float rs = row_rs(v);
        GAS f32x4* o = (GAS f32x4*)(h + (size_t)m * D) + F.lane;
#pragma unroll
        for (int j = 0; j < 4; ++j) o[64 * j] = v[j] * rs * g[j];
    }
}
__device__ __forceinline__ void rope_table_phase(const Frame& F, float* cs, float* sn) {
    for (int i = (F.vcu * NTHREADS + F.tid); i < SEQ * 128; i += F.G * NTHREADS) {
        const int pos = i >> 7, j = i & 127;
        const float inv = exp2f(-(float)j * (13.287712379549449f / 128.0f));
        const float ang = (float)pos * inv;
        const double a = (double)ang; const double n = rint(a * 0.63661977236758134);
        const double r = __builtin_fma(-n, 1.5707963267948966, a) - n * 6.123233995736766e-17;
        const double r2 = r * r;
        const double sr = r * (1.0 - r2 / 6.0 * (1.0 - r2 / 20.0 * (1.0 - r2 / 42.0 * (1.0 - r2 / 72.0 * (1.0 - r2 / 110.0 * (1.0 - r2 / 156.0))))));
        const double cr = 1.0 - r2 / 2.0 * (1.0 - r2 / 12.0 * (1.0 - r2 / 30.0 * (1.0 - r2 / 56.0 * (1.0 - r2 / 90.0 * (1.0 - r2 / 132.0 * (1.0 - r2 / 182.0))))));
        const int q = ((int)n) & 3;
        const double s_ = (q == 0) ? sr : (q == 1) ? cr : (q == 2) ? -sr : -cr;
        const double c_ = (q == 0) ? cr : (q == 1) ? -sr : (q == 2) ? -cr : sr;
        cs[i] = (float)c_; sn[i] = (float)s_;
    }
}
__device__ __forceinline__ void conv_phase(const Frame& F, const bf16* Bb, const bf16* Ub, bf16* Zb, const float* cw, const float* cb) {
    const int cg = F.tid & 127, tsub = F.tid >> 7, c0 = cg * 8;
    float w0[8], w1[8], w2[8], bi[8];
#pragma unroll
    for (int e = 0; e < 8; ++e) { w0[e] = cw[c0 + e]; w1[e] = cw[D + c0 + e]; w2[e] = cw[2 * D + c0 + e]; bi[e] = cb[c0 + e]; }
    for (int t = F.vcu * 4 + tsub; t < T; t += F.G * 4) {
        const int s = t & (SEQ - 1);
        const v4u zero = (v4u){0u, 0u, 0u, 0u};
        const v4u um = (s > 0) ? *(const GAS v4u*)(Ub + (size_t)(t - 1) * D + c0) : zero;
        const v4u u0 = *(const GAS v4u*)(Ub + (size_t)t * D + c0);
        const v4u up = (s < SEQ - 1) ? *(const GAS v4u*)(Ub + (size_t)(t + 1) * D + c0) : zero;
        const v4u bb = *(const GAS v4u*)(Bb + (size_t)t * D + c0);
        float z[8];
#pragma unroll
        for (int e2 = 0; e2 < 4; ++e2) {
            const unsigned a = um[e2], b = u0[e2], c = up[e2], g = bb[e2];
            z[2 * e2] = pg8::bf_lo(g) * (w0[2 * e2] * pg8::bf_lo(a) + w1[2 * e2] * pg8::bf_lo(b) + w2[2 * e2] * pg8::bf_lo(c) + bi[2 * e2]);
            z[2 * e2 + 1] = pg8::bf_hi(g) * (w0[2 * e2 + 1] * pg8::bf_hi(a) + w1[2 * e2 + 1] * pg8::bf_hi(b) + w2[2 * e2 + 1] * pg8::bf_hi(c) + bi[2 * e2 + 1]);
        }
        v4u o; o.x = pk2(z[0], z[1]); o.y = pk2(z[2], z[3]); o.z = pk2(z[4], z[5]); o.w = pk2(z[6], z[7]);
        *(GAS v4u*)(Zb + (size_t)t * D + c0) = o;
    }
}
__device__ __forceinline__ void convert_p_phase(const Frame& F, const float* p, bf16* pb) {
    const size_t n8 = (size_t)T * PLE / 8;
    for (size_t i = (size_t)F.vcu * NTHREADS + F.tid; i < n8; i += (size_t)F.G * NTHREADS) {
        const f32x4 a = *(const GAS f32x4*)(p + i * 8), b = *(const GAS f32x4*)(p + i * 8 + 4);
        v4u o; o.x = pk2(a.x, a.y); o.y = pk2(a.z, a.w); o.z = pk2(b.x, b.y); o.w = pk2(b.z, b.w);
        *(GAS v4u*)(pb + i * 8) = o;
    }
}
__device__ __forceinline__ float xchg_reduce(float keep, float send, int x) { return keep + __shfl_xor(send, x); }
__device__ __forceinline__ void router_phase(const Frame& F, const float* xin  , const bf16* delta, bf16* h16, const float* gain, const float* rw, bf16* hn, float* aff) {
    LAS float* rwl = (LAS float*)(F.lds + RING_OFF);
    for (int i = F.tid; i < D * NE; i += NTHREADS) { const int c = i >> 4, e = i & 15; rwl[e * D + c] = rw[i]; }
    __syncthreads();
    f32x4 g[4]; load_row(gain, F.lane, g);
    const int lane = F.lane;
    for (int m = F.gw; m < T; m += F.NGW) {
        asm volatile("" ::: "memory");
        f32x4 v[4]; if (xin) load_row(xin + (size_t)m * D, lane, v); else load_row_bf16(h16 + (size_t)m * D, lane, v);
        add_delta_row(delta + (size_t)m * D, lane, v); store_row_bf16(h16 + (size_t)m * D, lane, v);
        const float rs = row_rs(v);
#pragma unroll
        for (int j = 0; j < 4; ++j) v[j] = v[j] * rs * g[j];
        { GAS unsigned* o4 = (GAS unsigned*)((unsigned char*)hn + (size_t)m * D) + lane;
#pragma unroll
          for (int j = 0; j < 4; ++j) o4[64 * j] = pg8::pack4_i8(v[j] * QA_HN); }
        float lg[NE];
#pragma unroll
        for (int e = 0; e < NE; ++e) { float acc = 0.f;
#pragma unroll
            for (int j = 0; j < 4; ++j) { const f32x4 w = *(const LAS f32x4*)(rwl + e * D + 256 * j + 4 * lane); acc += v[j].x * w.x + v[j].y * w.y + v[j].z * w.z + v[j].w * w.w; }
            lg[e] = acc; }
        float r8[8], r4[4], r2[2], r1;
        { const bool up = (lane & 32) != 0;
#pragma unroll
          for (int i = 0; i < 8; ++i) r8[i] = xchg_reduce(up ? lg[8 + i] : lg[i], up ? lg[i] : lg[8 + i], 32); }
        { const bool up = (lane & 16) != 0;
#pragma unroll
          for (int i = 0; i < 4; ++i) r4[i] = xchg_reduce(up ? r8[4 + i] : r8[i], up ? r8[i] : r8[4 + i], 16); }
        { const bool up = (lane & 8) != 0;
#pragma unroll
          for (int i = 0; i < 2; ++i) r2[i] = xchg_reduce(up ? r4[2 + i] : r4[i], up ? r4[i] : r4[2 + i], 8); }
        { const bool up = (lane & 4) != 0; r1 = xchg_reduce(up ? r2[1] : r2[0], up ? r2[0] : r2[1], 4); }
        r1 += __shfl_xor(r1, 2); r1 += __shfl_xor(r1, 1);
        float mx = r1;
#pragma unroll
        for (int o = 4; o < 64; o <<= 1) mx = fmaxf(mx, __shfl_xor(mx, o));
        const float ex = expf(r1 - mx); float den = ex;
#pragma unroll
        for (int o = 4; o < 64; o <<= 1) den += __shfl_xor(den, o);
        const int e = ((lane >> 5) & 1) * 8 + ((lane >> 4) & 1) * 4 + ((lane >> 3) & 1) * 2 + ((lane >> 2) & 1);
        const int b = m >> 11, sq = m & (SEQ - 1);
        if ((lane & 3) == 0) aff[((size_t)b * NE + e) * SEQ + sq] = ex / den;
    }
    __syncthreads();
}
__device__ __forceinline__ void topk_phase(const Frame& F, const float* aff, int* tok, float* gate, int* inv) {
    LAS unsigned* cw = (LAS unsigned*)(F.lds + RING_OFF);
    LAS unsigned* pg = cw + 16;
    LAS unsigned* pe = pg + 32;
    const int w = F.wave, lane = F.lane;
    for (int item = F.vcu; item < BATCH * NE; item += F.G) {
        const int b = item / NE, e = item % NE;
        const float* src = aff + (size_t)item * SEQ;
        unsigned xv[4];
#pragma unroll
        for (int j = 0; j < 4; ++j) xv[j] = __float_as_uint(src[F.tid + NTHREADS * j]);
        unsigned thr = 0u;
        __syncthreads();
#pragma unroll 1
        for (int bit = 30; bit >= 0; --bit) {
            const unsigned cand = thr | (1u << bit);
            unsigned c = 0;
#pragma unroll
            for (int j = 0; j < 4; ++j) c += (unsigned)__popcll(__ballot(xv[j] >= cand));
            LAS unsigned* slot = cw + (bit & 1) * 8;
            if (lane == 0) slot[w] = c;
            __syncthreads();
            unsigned tot = 0;
#pragma unroll
            for (int ww = 0; ww < 8; ++ww) tot += slot[ww];
            if (tot >= (unsigned)CAP) thr = cand;
        }
        unsigned long long mg[4], me[4];
#pragma unroll
        for (int j = 0; j < 4; ++j) { mg[j] = __ballot(xv[j] > thr); me[j] = __ballot(xv[j] == thr);
            if (lane == 0) { pg[j * 8 + w] = (unsigned)__popcll(mg[j]); pe[j * 8 + w] = (unsigned)__popcll(me[j]); } }
        __syncthreads();
        unsigned totg = 0;
#pragma unroll
        for (int i = 0; i < 32; ++i) totg += pg[i];
        const unsigned long long below = (1ull << lane) - 1ull;
#pragma unroll
        for (int j = 0; j < 4; ++j) {
            unsigned bg = 0, be = 0;
            for (int i = 0; i < j * 8 + w; ++i) { bg += pg[i]; be += pe[i]; }
            const unsigned rg = bg + (unsigned)__popcll(mg[j] & below), re = be + (unsigned)__popcll(me[j] & below);
            const int me_i = F.tid + NTHREADS * j;
            int slot = -1;
            if (xv[j] > thr) slot = (int)rg; else if (xv[j] == thr && totg + re < (unsigned)CAP) slot = (int)(totg + re);
            if (slot >= 0) { const size_t o = ((size_t)e * BATCH + b) * CAP + slot; tok[o] = me_i; gate[o] = __uint_as_float(xv[j]); }
            inv[((size_t)b * SEQ + me_i) * NE + e] = slot;
        }
    }
    __syncthreads();
}
__device__ __forceinline__ void combine_phase(const Frame& F, bf16* h16, const bf16* Y, const int* inv, const float* gain, bf16* hb) {
    f32x4 g[4]; load_row(gain, F.lane, g);
    int inv_next = (F.lane < NE && F.gw < T) ? inv[(size_t)F.gw * NE + F.lane] : -1;
    for (int m = F.gw; m < T; m += F.NGW) {
        const int b = m >> 11;
        const int myinv = inv_next;
        { const int mn = m + F.NGW; inv_next = (F.lane < NE && mn < T) ? inv[(size_t)mn * NE + F.lane] : -1; }
        f32x4 v[4]; load_row_bf16(h16 + (size_t)m * D, F.lane, v);
        unsigned mk = (unsigned)__ballot(myinv >= 0) & 0xffffu;
        const unsigned e0 = mk ? (unsigned)__builtin_ctz(mk) : 0u;
        unsigned long long yv[4][4]; float wk[4];
#pragma unroll
        for (int k = 0; k < 4; ++k) {
            const bool have = mk != 0u; const unsigned e = have ? (unsigned)__builtin_ctz(mk) : e0; if (have) mk &= mk - 1u;
            int slot = __builtin_amdgcn_readlane(myinv, (int)e); if (slot < 0) slot = 0;
            wk[k] = have ? 1.0f : 0.0f;
            const GAS unsigned long long* yr = (const GAS unsigned long long*)(Y + (((size_t)e * BATCH + b) * CAP + slot) * D) + F.lane;
#pragma unroll
            for (int j = 0; j < 4; ++j) yv[k][j] = yr[64 * j];
        }
#pragma unroll
        for (int k = 0; k < 4; ++k)
#pragma unroll
            for (int j = 0; j < 4; ++j) { const unsigned lo = (unsigned)yv[k][j], hi = (unsigned)(yv[k][j] >> 32);
                v[j].x += wk[k] * pg8::bf_lo(lo); v[j].y += wk[k] * pg8::bf_hi(lo); v[j].z += wk[k] * pg8::bf_lo(hi); v[j].w += wk[k] * pg8::bf_hi(hi); }
        while (mk) {
            const unsigned e = (unsigned)__builtin_ctz(mk); mk &= mk - 1u;
            const int slot = __builtin_amdgcn_readlane(myinv, (int)e);
            const GAS unsigned long long* yr = (const GAS unsigned long long*)(Y + (((size_t)e * BATCH + b) * CAP + slot) * D) + F.lane;
#pragma unroll
            for (int j = 0; j < 4; ++j) { const unsigned long long w = yr[64 * j]; const unsigned lo = (unsigned)w, hi = (unsigned)(w >> 32);
                v[j].x += pg8::bf_lo(lo); v[j].y += pg8::bf_hi(lo); v[j].z += pg8::bf_lo(hi); v[j].w += pg8::bf_hi(hi); }
        }
        store_row_bf16(h16 + (size_t)m * D, F.lane, v);
        const float rs = row_rs(v);
#pragma unroll
        for (int j = 0; j < 4; ++j) v[j] = v[j] * rs * g[j];
        { GAS unsigned* o4 = (GAS unsigned*)((unsigned char*)hb + (size_t)m * D) + F.lane;
#pragma unroll
          for (int jj = 0; jj < 4; ++jj) o4[64 * jj] = pg8::pack4_i8(v[jj] * QA_HN); }
    }
}

namespace ret {
using pg8::i32x4; using pg8::f32x2;
typedef unsigned u32x4 __attribute__((ext_vector_type(4)));
typedef unsigned u32x2 __attribute__((ext_vector_type(2)));
constexpr int KROW = 288  , KBUF = 9216, PROW = 80, PBUF = 10240;
constexpr float QK_LSC = -14.0f;
constexpr int K_OFF = 0, P_OFF = 2 * KBUF, ST1_OFF = P_OFF + 2 * PBUF, ST2_OFF = ST1_OFF + 8192, RET_LDS_END = ST2_OFF + 1024;
static_assert(RET_LDS_END <= LDS_BYTES - 512, "retention LDS map");
constexpr int NCHUNK = SEQ / 32;

__device__ __forceinline__ void retention_phase(const Frame& F, const unsigned char* Q, const unsigned char* Kk, const bf16* VT, const bf16* G, unsigned char* O8, const float* logdecay, bool do_store) {
    LAS unsigned char* lds = F.lds;
    const int w = F.wave;
    int lane_ = F.lane; asm volatile("" : "+v"(lane_)); const int lane = lane_;
    unsigned offK[2];
#pragma unroll
    for (int k = 0; k < 2; ++k) { const int ci = 64 * (w + 8 * k) + lane; int row = ci / 18, cc = ci % 18; if (row > 31) row = 31; if (cc >= 16) cc = 0; offK[k] = (unsigned)(row * 256 + cc * 16); }
    const int cq = lane & 15, q4 = lane >> 4, r = lane & 31, hf = lane >> 5;
    const unsigned voff = (unsigned)((64 * w + r) * 64 + 16 * hf);

    for (int unit = F.vcu; unit < BATCH * RH * 16; unit += F.G) {
        static_assert(BATCH * RH * 16 == 2048, "retention unit map");
        const int rk = unit >> 8, sl = unit & 255, g_ = sl >> 4;
        const int b = (g_ >> 2) * 8 + rk, hd = ((g_ & 3) + rk) & 3, qt = ((sl & 15) + 2 * rk) & 15, bh = b * 4 + hd;
        const char* kg = (const char*)(Kk + (size_t)bh * SEQ * RQK);
        const char* vg = (const char*)(VT + (size_t)bh * RV * SEQ);
        const float lf2 = logdecay[hd] * 1.44269504089f, lb2 = logdecay[4 + hd] * 1.44269504089f;
        int c0, nck;
        { const float kf_ = 24.0f / fmaxf(-lf2, 1e-6f), kb_ = 24.0f / fmaxf(-lb2, 1e-6f);
          int lo_ = (int)floorf(fmaxf((float)(qt * 128) - kf_, 0.f) * (1.0f / 32.0f)), hi_ = (int)floorf(fminf((float)(qt * 128 + 127) + kb_, (float)(SEQ - 1)) * (1.0f / 32.0f));
          if (((hi_ - lo_) & 1) == 0) { if (lo_ > 0) --lo_; else ++hi_; }
          c0 = __builtin_amdgcn_readfirstlane(lo_); nck = __builtin_amdgcn_readfirstlane(hi_ - lo_ + 1); }
#define RET_DMA_K(c, buf) do { \
        _Pragma("unroll") for (int k = 0; k < 2; ++k) if (w + 8 * k < 9) { unsigned o_ = offK[k]; asm volatile("" : "+v"(o_)); \
            __builtin_amdgcn_global_load_lds((const unsigned*)(kg + (size_t)(c) * (32 * 256) + o_), (LAS unsigned*)(lds + K_OFF + (buf) * KBUF + (w + 8 * k) * 1024), 16, 0, 0); } } while (0)
  \
#define RET_LD_V(c, dst) do { unsigned o_ = voff; asm volatile("" : "+v"(o_)); const char* vp_ = vg + (size_t)(c) * 32768 + o_; \
        asm volatile("global_load_dwordx4 %0, %1, off" : "=v"(dst[0][0]) : "v"(vp_)); asm volatile("global_load_dwordx4 %0, %1, off offset:32" : "=v"(dst[0][1]) : "v"(vp_)); \
        asm volatile("global_load_dwordx4 %0, %1, off offset:2048" : "=v"(dst[1][0]) : "v"(vp_)); asm volatile("global_load_dwordx4 %0, %1, off offset:2080" : "=v"(dst[1][1]) : "v"(vp_)); } while (0)
#define RET_S(c, buf) do { i32x4 sa_[2]; \
        _Pragma("unroll") for (int blk = 0; blk < 2; ++blk) { \
            i32x4 sacc = (i32x4){0, 0, 0, 0}; \
            const LAS unsigned char* kp = lds + K_OFF + (buf) * KBUF + (16 * blk + cq) * KROW + 16 * q4; \
            _Pragma("unroll") for (int s_ = 0; s_ < 4; ++s_) { const i32x4 kf = *(const LAS i32x4*)(kp + 64 * s_); sacc = __builtin_amdgcn_mfma_i32_16x16x64_i8(kf, qf[s_], sacc, 0, 0, 0); } \
            sa_[blk] = sacc; } \
          \
        _Pragma("unroll") for (int blk = 0; blk < 2; ++blk) { \
            const float fd0 = (float)(nq - (32 * (c) + 16 * blk + 4 * q4)); float pv[4]; \
              \
            _Pragma("unroll") for (int e = 0; e < 4; e += 2) { const f32x2 fd = (f32x2){fd0, fd0} - (f32x2){(float)e, (float)(e + 1)}; \
                const f32x2 xa = fd * (f32x2){lf2, lf2} + (f32x2){QK_LSC, QK_LSC}, xb = fd * (f32x2){-lb2, -lb2} + (f32x2){QK_LSC, QK_LSC}; \
                const f32x2 pw_ = (f32x2){(float)sa_[blk][e], (float)sa_[blk][e + 1]} * (f32x2){__builtin_amdgcn_exp2f(fminf(xa[0], xb[0])), __builtin_amdgcn_exp2f(fminf(xa[1], xb[1]))}; \
                pv[e] = pw_[0]; pv[e + 1] = pw_[1]; } \
            v2u pw; pw.x = pg8::cvt_pk_bf16(pv[0], pv[1]); pw.y = pg8::cvt_pk_bf16(pv[2], pv[3]); \
            *(LAS v2u*)(lds + P_OFF + (buf) * PBUF + (16 * w + cq) * PROW + (16 * blk + 4 * q4) * 2) = pw; } } while (0)
#define RET_PV(vr, pbuf) do { \
        _Pragma("unroll") for (int s_ = 0; s_ < 2; ++s_) { bf16x8 pf[4]; \
            _Pragma("unroll") for (int i = 0; i < 4; ++i) pf[i] = *(const LAS bf16x8*)(lds + P_OFF + (pbuf) * PBUF + (32 * i + r) * PROW + 32 * s_ + 16 * hf); \
            _Pragma("unroll") for (int jb = 0; jb < 2; ++jb) _Pragma("unroll") for (int i = 0; i < 4; ++i) OT[jb][i] = __builtin_amdgcn_mfma_f32_32x32x16_bf16(vr[jb][s_], pf[i], OT[jb][i], 0, 0, 0); } } while (0)
#define RET_TOP() do { VM_WAIT(); LDS_WAIT(); __builtin_amdgcn_s_barrier(); asm volatile("" ::: "memory"); } while (0)
        i32x4 qf[4];
        { const unsigned char* qrow = Q + ((size_t)bh * SEQ + qt * 128 + 16 * w + cq) * RQK + 16 * q4;
#pragma unroll
          for (int s = 0; s < 4; ++s) qf[s] = *(const GAS i32x4*)(qrow + 64 * s); }
        RET_DMA_K(c0, 0);
        f32x16 OT[2][4];
#pragma unroll
        for (int jb = 0; jb < 2; ++jb)
#pragma unroll
            for (int i = 0; i < 4; ++i)
#pragma unroll
                for (int e = 0; e < 16; ++e) OT[jb][i][e] = 0.f;
        const int nq = qt * 128 + 16 * w + cq;
        bf16x8 v0[2][2], v1[2][2];
#define RET_SP_A(c, kb, vr, pb) do { RET_S(c, kb); RET_PV(vr, pb); } while (0)
#define RET_SP_B(c, kb, vr, pb) do { RET_PV(vr, pb); RET_S(c, kb); } while (0)
#define RET_SEQ(SP) do { \
          \
        RET_TOP(); RET_DMA_K(c0 + 1, 1); RET_LD_V(c0, v0); RET_S(c0, 0); \
        _Pragma("unroll 1") for (int i = 1; i < nck - 1; i += 2) { const int c = c0 + i; \
              \
            RET_TOP(); RET_DMA_K(c + 1, 0); RET_LD_V(c, v1); SP(c, 1, v0, 0); \
              \
            RET_TOP(); RET_DMA_K(c + 2, 1); RET_LD_V(c + 1, v0); SP(c + 1, 0, v1, 1); \
        } \
          \
        RET_TOP(); RET_LD_V(c0 + nck - 1, v1); SP(c0 + nck - 1, 1, v0, 0); \
        RET_TOP(); RET_PV(v1, 1); } while (0)
        if (w < 4) RET_SEQ(RET_SP_A); else RET_SEQ(RET_SP_B);
#undef RET_SEQ
#undef RET_SP_A
#undef RET_SP_B
        LAS float* st1 = (LAS float*)(lds + ST1_OFF); LAS float* st2 = (LAS float*)(lds + ST2_OFF);
        u32x4 sgv[4][2][2];
        { int le_ = lane; asm volatile("" : "+v"(le_));
#pragma unroll
          for (int i = 0; i < 4; ++i) { const bf16* grow = G + ((size_t)b * SEQ + qt * 128 + 32 * i + (le_ & 31)) * RVW + hd * RV + 64 * w + 8 * (le_ >> 5);
#pragma unroll
            for (int jb = 0; jb < 2; ++jb)
#pragma unroll
                for (int ap = 0; ap < 2; ++ap) sgv[i][jb][ap] = *(const GAS u32x4*)(grow + 32 * jb + 16 * ap); } }
#pragma unroll
        for (int i = 0; i < 4; ++i) { float s1 = 0.f, s2 = 0.f;
#pragma unroll
            for (int jb = 0; jb < 2; ++jb)
#pragma unroll
                for (int e = 0; e < 16; ++e) { const float v = OT[jb][i][e]; s1 += v; s2 += v * v; }
            s1 += __shfl_xor(s1, 32); s2 += __shfl_xor(s2, 32);
            if (hf == 0) { st1[(w * 128 + 32 * i + r) * 2] = s1; st1[(w * 128 + 32 * i + r) * 2 + 1] = s2; } }
        LDS_WAIT(); __syncthreads();
        if (F.tid < 128) { float S1 = 0.f, S2 = 0.f;
#pragma unroll
            for (int ww = 0; ww < 8; ++ww) { S1 += st1[(ww * 128 + F.tid) * 2]; S2 += st1[(ww * 128 + F.tid) * 2 + 1]; }
            const float mean = S1 * (1.f / RV); const float var = fmaxf(S2 * (1.f / RV) - mean * mean, 0.f);
            st2[F.tid * 2] = mean; st2[F.tid * 2 + 1] = 1.0f / sqrtf(var + GN_EPS); }
        LDS_WAIT(); __syncthreads();
#pragma unroll
        for (int i = 0; i < 4; ++i) { const float mean = st2[(32 * i + r) * 2], rstd = st2[(32 * i + r) * 2 + 1]; const float rs = rstd * QA_OG, mb = -mean * rs;
            unsigned char* orow = O8 + ((size_t)b * SEQ + qt * 128 + 32 * i + r) * RVW + hd * RV + 64 * w + 8 * hf;
#pragma unroll
            for (int jb = 0; jb < 2; ++jb)
#pragma unroll
                for (int ap = 0; ap < 2; ++ap) { const u32x4 L = sgv[i][jb][ap];
                    const u32x2 sx = __builtin_amdgcn_permlane32_swap(L.x, L.z, false, false), sy = __builtin_amdgcn_permlane32_swap(L.y, L.w, false, false);
                    unsigned ow[2];
#pragma unroll
                    for (int q = 0; q < 2; ++q) { const int g4 = 2 * ap + q; const unsigned s0 = q ? sx.y : sx.x, s1 = q ? sy.y : sy.x;
                        const f32x4 ov = (f32x4){OT[jb][i][4 * g4 + 0], OT[jb][i][4 * g4 + 1], OT[jb][i][4 * g4 + 2], OT[jb][i][4 * g4 + 3]} * (f32x4){rs, rs, rs, rs} + (f32x4){mb, mb, mb, mb};
                        ow[q] = pg8::pack4_i8(ov * (f32x4){pg8::bf_lo(s0), pg8::bf_hi(s0), pg8::bf_lo(s1), pg8::bf_hi(s1)}); }
                    const u32x2 tx = __builtin_amdgcn_permlane32_swap(ow[0], ow[1], false, false);
                    v2u o8; o8.x = tx.x; o8.y = tx.y;
                    if (do_store) *(GAS v2u*)(orow + 32 * jb + 16 * ap) = o8; } }
        __syncthreads();
#undef RET_DMA_K
#undef RET_LD_V
#undef RET_S
#undef RET_PV
#undef RET_TOP
    }
}
}

constexpr int N_PHASES = 24;
__device__ __forceinline__ unsigned char* opq(unsigned char* p) { asm volatile("" : "+s"(p)); return p; }
__global__ void __launch_bounds__(NTHREADS, 2) enc_fwd(Args a) {
    extern __shared__ __attribute__((aligned(16))) unsigned char lds_raw[];
    Frame F;
    F.lds = (LAS unsigned char*)lds_raw;
    F.tid = threadIdx.x; F.lane = F.tid & 63; F.wave = __builtin_amdgcn_readfirstlane(F.tid >> 6);
    F.G = gridDim.x; { const int bx = blockIdx.x; F.vcu = (F.G % 8 == 0) ? (bx % 8) * (F.G / 8) + bx / 8 : bx; }
    F.gw = F.vcu * NWAVES + F.wave; F.NGW = F.G * NWAVES;
    volatile LAS unsigned* MISC = (volatile LAS unsigned*)(F.lds + MISC_OFF);
    for (int u = F.tid; u < (LDS_BYTES - MISC_OFF) / 4; u += NTHREADS) ((LAS unsigned*)(F.lds + MISC_OFF))[u] = 0u;
    __syncthreads();
    unsigned char* ws = a.ws;
    XcdBarrier bar = xcd_barrier_post((unsigned*)(ws + WS_CTL) + CW_BAR, MISC + 8);
    const int lo = a.ph_lo, hi = a.ph_hi;
#ifndef MK_MASK
#define MK_MASK 0xFFFFFFu
#endif
#define EN(k) (((MK_MASK) >> (k)) & 1u)
#define REP(k) for (int rep_ = 0; rep_ < ((MK_DUP == (k)) ? 2 : 1); ++rep_)
#define RUN(k) (lo <= (k) && (k) < hi)
#define SEAM(k) do { if (RUN(k) && RUN((k) + 1)) xcd_barrier(bar); } while (0)

#define h (a.out)
#define h16 ((bf16*)(opq(a.ws) + WS_H16))
#define hb ((bf16*)(opq(a.ws) + WS_HB))
#define aff ((float*)(opq(a.ws) + WS_AFF))
#define inv ((int*)(opq(a.ws) + WS_INV))
#define tok ((int*)(opq(a.ws) + WS_TOK))
#define gate ((float*)(opq(a.ws) + WS_GATE))
#define rcs ((float*)(opq(a.ws) + WS_ROPE))
#define rsn ((float*)(opq(a.ws) + WS_ROPE) + SEQ * 128)
#define wci ((bf16*)(opq(a.ws) + WS_WCI))
#define wco ((bf16*)(opq(a.ws) + WS_WCO))
#define wri ((bf16*)(opq(a.ws) + WS_WRI))
#define wrv ((bf16*)(opq(a.ws) + WS_WRI) + (size_t)4096 * (MK_RET_I8 ? D / 2 : D))
#define wro ((bf16*)(opq(a.ws) + WS_WRO))
#define wpg ((bf16*)(opq(a.ws) + WS_WPG))
#define wpp ((bf16*)(opq(a.ws) + WS_WPP))
#define we1 ((bf16*)(opq(a.ws) + WS_WE1))
#define we2 ((bf16*)(opq(a.ws) + WS_WE2))
#define scr (opq(a.ws) + WS_SCR)
#define tscr ((LAS float*)(F.lds + RING_OFF + F.wave * 16384))
#define ring (F.lds + RING_OFF)
    if (EN(0) && RUN(0)) {
        transpose_matrix<8>(F, a.conv_w_in, D, 3 * D, wci, tscr);
        transpose_matrix<0>(F, a.conv_w_out, D, D, wco, tscr);
        transpose_matrix<MK_RET_I8 ? 7 : 4>(F, a.ret_w_in, D, 6 * D, wri, tscr);
        transpose_matrix<5>(F, a.ret_w_out, RVW, D, wro, tscr);
        for (int l = 0; l < 2; ++l) {
            transpose_matrix<6>(F, a.ple_w_gate + (size_t)l * D * D, D, D, wpg + (size_t)l * D * (D / 2), tscr);
            transpose_matrix<0>(F, a.ple_w_proj + (size_t)l * PLE * D, PLE, D, wpp + (size_t)l * D * PLE, tscr);
        }
        convert_experts(F, a, 0, tscr);
        rope_table_phase(F, rcs, rsn);
        norm_rows_phase(F, a.x, nullptr, nullptr, a.norm_mix, hb, true);
    }
    SEAM(0);

    if (EN(1) && RUN(1)) {
        pg8::StaticOrder S; S.init(T, 3 * D, F.G, (int)blockIdx.x);
        pg8::SrcPlain X{hb, wci, D / 2};
        pg8::EpiConvIn E{(bf16*)(scr + SC_CB), (bf16*)(scr + SC_CU), 1.0f / (QA_HN * QW_1024)};
        pg8::gemm_phase<1>(ring, S, X, E);
    }
    SEAM(1);
    if (EN(2) && RUN(2)) REP(2) conv_phase(F, (const bf16*)(scr + SC_CB), (const bf16*)(scr + SC_CU), (bf16*)(scr + SC_CZ), a.conv_w, a.conv_b);
    SEAM(2);
    if (EN(3) && RUN(3)) {
        pg8::StaticOrder S; S.init(T, D, F.G, (int)blockIdx.x);
        pg8::SrcPlain X{(const bf16*)(scr + SC_CZ), wco, D};
        pg8::EpiBf16 E{(bf16*)(scr + SC_D0), D, 1.0f};
        pg8::gemm_phase<0>(ring, S, X, E);
    }
    SEAM(3);
#define MOE_BLOCK(l, pb) \
    if (EN(4) && RUN(pb + 0)) REP(pb + 0) router_phase(F, (l == 0) ? a.x : (const float*)nullptr, (const bf16*)(scr + ((l == 0) ? SC_D0 : SC_D7)), h16, a.norm_ffn + (size_t)l * D, a.router_w + (size_t)l * D * NE, hb, aff); \
    SEAM(pb + 0); \
    if (EN(5) && RUN(pb + 1)) REP(pb + 1) topk_phase(F, aff, tok, gate, inv); \
    SEAM(pb + 1); \
    if (EN(6) && RUN(pb + 2)) { \
        pg8::ExpertOrder S; S.init(16, F.G, (int)blockIdx.x); \
        LAS unsigned short* tl = (LAS unsigned short*)(F.lds + TOK_OFF); \
        for (int k = 0; k < 16; ++k) { const int i = 2 * k + (F.tid >> 8), rr = F.tid & 255; pg8::Unit u; if (S.next(i, u)) tl[i * 256 + rr] = (unsigned short)tok[u.pm * 256 + rr]; } \
        __syncthreads(); \
        pg8::SrcExpert1 X{hb, we1, D / 2, tl}; \
        pg8::EpiSwiglu E{(bf16*)(scr + SC_ACT)}; \
        pg8::gemm_phase<1>(ring, S, X, E); \
    } \
    SEAM(pb + 2); \
    if (EN(7) && RUN(pb + 3)) { \
        pg8::ExpertOrder S; S.init(4, F.G, (int)blockIdx.x); \
        pg8::SrcExpert2 X{(const bf16*)(scr + SC_ACT), we2, FF / 2}; \
        pg8::EpiDown E{(bf16*)(scr + SC_Y), gate}; \
        pg8::gemm_phase<1>(ring, S, X, E); \
    } \
    SEAM(pb + 3); \
    if (EN(8) && RUN(pb + 4)) { \
        combine_phase(F, h16, (const bf16*)(scr + SC_Y), inv, a.norm_ple + (size_t)l * D, hb); \
        convert_p_phase(F, a.p + (size_t)l * T * PLE, (bf16*)(scr + SC_PB)); \
        if (l == 0) convert_experts(F, a, 1, tscr); \
    } \
    SEAM(pb + 4); \
    if (EN(9) && RUN(pb + 5)) { \
        pg8::StaticOrder S; S.init(T, D, F.G, (int)blockIdx.x); \
        pg8::SrcPlain X{(const bf16*)(scr + SC_PB), wpp + (size_t)l * D * PLE, PLE}; \
        pg8::EpiI8 E{(unsigned char*)(scr + SC_PP), D, QA_PP}; \
        pg8::gemm_phase<0>(ring, S, X, E); \
    } \
    SEAM(pb + 5); \
    if (EN(10) && RUN(pb + 6)) { \
        pg8::StaticOrder S; S.init(T, D, F.G, (int)blockIdx.x); \
        pg8::SrcPlain X{hb, wpg + (size_t)l * D * (D / 2), D / 2}; \
        pg8::EpiPle E{(unsigned char*)(scr + SC_T), (const unsigned char*)(scr + SC_PP)}; \
        pg8::gemm_phase<1>(ring, S, X, E); \
    } \
    SEAM(pb + 6);
    MOE_BLOCK(0, 4)
    if (EN(11) && RUN(11)) REP(11) norm_rows_phase(F, nullptr, h16, (const bf16*)(scr + SC_T), a.norm_mix + D, hb, MK_RET_I8 != 0);
    SEAM(11);
    if (EN(12) && RUN(12)) {
        pg8::StaticOrder S; S.init(T, 4096, F.G, (int)blockIdx.x);
        pg8::SrcPlain X{hb, wri, MK_RET_I8 ? D / 2 : D};
        pg8::EpiRetIn E{(unsigned char*)(scr + SC_Q), (unsigned char*)(scr + SC_K), (bf16*)(scr + SC_G), rcs, rsn, MK_RET_I8 ? 1.0f / (QA_HN * QW_1024) : 1.0f};
        pg8::gemm_phase<MK_RET_I8 ? 1 : 0>(ring, S, X, E);
    }
    if (EN(13) && RUN(13)) {
        pg8::StaticOrder S; S.init(RVW, T, F.G, (int)blockIdx.x);
        pg8::SrcPlain X{wrv, hb, MK_RET_I8 ? D / 2 : D};
        pg8::EpiVT E{(bf16*)(scr + SC_VT), MK_RET_I8 ? 1.0f / (QA_HN * QW_1024) : 1.0f};
        pg8::gemm_phase<MK_RET_I8 ? 1 : 0>(ring, S, X, E);
    }
    SEAM(13);
    if (EN(14) && RUN(14)) REP(14) ret::retention_phase(F, (const unsigned char*)(scr + SC_Q), (const unsigned char*)(scr + SC_K), (const bf16*)(scr + SC_VT), (const bf16*)(scr + SC_G), (unsigned char*)hb, a.ret_log_decay, (MK_DUP != 14) || rep_ == 1 || a.ph_hi == 12345);
    SEAM(14);
    if (EN(15) && RUN(15)) {
        pg8::StaticOrder S; S.init(T, D, F.G, (int)blockIdx.x);
        pg8::SrcPlain X{hb, wro, RVW / 2};
        pg8::EpiBf16 E{(bf16*)(scr + SC_D7), D, 1.0f / (QA_OG * QW_2048)};
        pg8::gemm_phase<1>(ring, S, X, E);
    }
    SEAM(15);
    MOE_BLOCK(1, 16)
#undef MOE_BLOCK
    if (EN(23) && RUN(23)) REP(23) final_rows_phase(F, h, h16, (const bf16*)(scr + SC_T), a.final_norm);
#undef RUN
#undef SEAM
#undef h
#undef h16
#undef hb
#undef aff
#undef inv
#undef tok
#undef gate
#undef rcs
#undef rsn
#undef wci
#undef wco
#undef wri
#undef wrv
#undef wro
#undef wpg
#undef wpp
#undef we1
#undef we2
#undef scr
#undef tscr
#undef ring
}

extern "C" void kernel_launch(void* const* d_in, const int* in_sizes, int n_in, void* d_out, int out_size, void* d_ws, size_t ws_size, hipStream_t stream) {
    static int grid = 0;
    if (grid == 0) {
        if (n_in != 19 || in_sizes[0] != T * D || out_size != T * D || ws_size < WS_END) { fprintf(stderr, "kernel_launch: unexpected shapes/workspace (n_in %d, ws %zu); nothing launched\n", n_in, ws_size); grid = -1; return; }
        int dev = 0, cus = 0, per_cu = 0;
        if (hipGetDevice(&dev) != hipSuccess || hipDeviceGetAttribute(&cus, hipDeviceAttributeMultiprocessorCount, dev) != hipSuccess) { grid = -1; return; }
        if (hipFuncSetAttribute((const void*)enc_fwd, hipFuncAttributeMaxDynamicSharedMemorySize, LDS_BYTES) != hipSuccess) { fprintf(stderr, "kernel_launch: hipFuncSetAttribute failed\n"); grid = -1; return; }
        if (hipOccupancyMaxActiveBlocksPerMultiprocessor(&per_cu, (const void*)enc_fwd, NTHREADS, LDS_BYTES) != hipSuccess || per_cu < 1) { fprintf(stderr, "kernel_launch: occupancy query reports %d\n", per_cu); }
        (void)hipGetLastError();
        grid = cus;
    }
    if (grid < 0) return;
    if (hipMemsetAsync((char*)d_ws + WS_CTL, 0, CTL_ZERO_BYTES, stream) != hipSuccess) return;
    Args a{};
    a.x = (const float*)d_in[0]; a.p = (const float*)d_in[1]; a.norm_mix = (const float*)d_in[2]; a.norm_ffn = (const float*)d_in[3]; a.norm_ple = (const float*)d_in[4]; a.final_norm = (const float*)d_in[5];
    a.conv_w_in = (const float*)d_in[6]; a.conv_w = (const float*)d_in[7]; a.conv_b = (const float*)d_in[8]; a.conv_w_out = (const float*)d_in[9];
    a.ret_w_in = (const float*)d_in[10]; a.ret_log_decay = (const float*)d_in[11]; a.ret_w_out = (const float*)d_in[12]; a.router_w = (const float*)d_in[13];
    a.exp_w_gate = (const float*)d_in[14]; a.exp_w_up = (const float*)d_in[15]; a.exp_w_down = (const float*)d_in[16]; a.ple_w_proj = (const float*)d_in[17]; a.ple_w_gate = (const float*)d_in[18];
    a.out = (float*)d_out; a.ws = (unsigned char*)d_ws;
#if MK_PER_PHASE
    for (int ph = 0; ph < N_PHASES; ++ph) { a.ph_lo = ph; a.ph_hi = ph + 1; hipLaunchKernelGGL(enc_fwd, dim3(grid), dim3(NTHREADS), LDS_BYTES, stream, a); }
#else
    a.ph_lo = 0; a.ph_hi = N_PHASES;
    hipLaunchKernelGGL(enc_fwd, dim3(grid), dim3(NTHREADS), LDS_BYTES, stream, a);
#endif
    const hipError_t le = hipPeekAtLastError();
    if (le != hipSuccess) fprintf(stderr, "kernel_launch: launch failed: %s\n", hipGetErrorName(le));
}
```
